# Optimizing an MI355X kernel written in HIP

```python
import numpy as np
import jax
import jax.numpy as jnp
from jax import lax


D_MODEL = 1024
BATCH = 2
SEQ = 8192
DEPTH = 4

GRID_W = 64
CTX_LEN = 256
ROPE_THETA = 10000.0
Q_BLOCK = 128
LN_EPS = 1e-6
RMS_EPS = 1e-6
DEEPNORM_ALPHA = (2 * DEPTH) ** 0.25
DEEPNORM_BETA = (8 * DEPTH) ** -0.25

GLA_HEADS = 4
GLA_DK = 32
GLA_DV = 64
GLA_GATE_RANK = 16
GLA_TAU = 16.0
GLA_CHUNK = 64
MLA_HEADS = 6
MLA_Q_RANK = 384
MLA_KV_RANK = 256
MLA_NOPE = 64
MLA_ROPE = 32
MLA_DV = 64
MLA_SCALE = (MLA_NOPE + MLA_ROPE) ** -0.5
GQA_HEADS = 6
GQA_KV_HEADS = 2
GQA_DH = 64
GQA_GROUP = GQA_HEADS // GQA_KV_HEADS
GQA_SCALE = GQA_DH ** -0.5
N_EXPERTS = 16
EC_CAPACITY_FACTOR = 2
D_EXPERT = 1024

GLA_WIDTH = GLA_HEADS * GLA_DV
MLA_WIDTH = MLA_HEADS * MLA_DV
GQA_WIDTH = GQA_HEADS * GQA_DH
MIX_WIDTH = GLA_WIDTH + MLA_WIDTH + GQA_WIDTH
IN_SPLITS = (GLA_HEADS * GLA_DK, GLA_HEADS * GLA_DK, GLA_WIDTH, GLA_WIDTH, GLA_GATE_RANK, GLA_GATE_RANK,
             MLA_Q_RANK, MLA_KV_RANK, MLA_ROPE,
             GQA_HEADS * GQA_DH, GQA_KV_HEADS * GQA_DH, GQA_KV_HEADS * GQA_DH)
IN_WIDTH = sum(IN_SPLITS)
IN_OFFSETS = [int(o) for o in np.cumsum(IN_SPLITS)[:-1]]

kernel_name = 'hybrid_gla_mla_gqa_ec_moe_diffusion_block'


def layer_norm(x, g, b):
    xf = x.astype(jnp.float32)
    mu = jnp.mean(xf, axis=-1, keepdims=True)
    var = jnp.mean(jnp.square(xf - mu), axis=-1, keepdims=True)
    return ((xf - mu) * lax.rsqrt(var + LN_EPS) * g.astype(jnp.float32) + b.astype(jnp.float32)).astype(x.dtype)


def rms_norm(x, g):
    xf = x.astype(jnp.float32)
    ms = jnp.mean(jnp.square(xf), axis=-1, keepdims=True)
    return (xf * lax.rsqrt(ms + RMS_EPS) * g.astype(jnp.float32)).astype(x.dtype)


def rope_1d(x, pos):
    half = x.shape[-1] // 2
    inv_freq = ROPE_THETA ** (-jnp.arange(half, dtype=jnp.float32) / half)
    ang = pos.astype(jnp.float32)[:, None] * inv_freq
    cos = jnp.cos(ang)[:, None, :]
    sin = jnp.sin(ang)[:, None, :]
    xf = x.astype(jnp.float32)
    x1, x2 = xf[..., :half], xf[..., half:]
    return jnp.concatenate([x1 * cos - x2 * sin, x1 * sin + x2 * cos], axis=-1).astype(x.dtype)


def rope_2d(x, row, col):
    half = x.shape[-1] // 2
    return jnp.concatenate([rope_1d(x[..., :half], row), rope_1d(x[..., half:], col)], axis=-1)


def blocked_attention(q, k, v, scale):
    B, Lq = q.shape[0], q.shape[1]
    nb = Lq // Q_BLOCK
    qb = q.reshape((B, nb, Q_BLOCK) + q.shape[2:]).swapaxes(0, 1)

    def one_block(q_blk):
        s = jnp.einsum('bqhgd,bkhd->bhgqk', q_blk, k).astype(jnp.float32) * scale
        p = jax.nn.softmax(s, axis=-1)
        return jnp.einsum('bhgqk,bkhe->bqhge', p.astype(v.dtype), v)

    ob = lax.map(one_block, qb)
    return ob.swapaxes(0, 1).reshape((B, Lq) + ob.shape[3:])


def gla_chunked(q, k, v, log_a, s0):
    B, L, H, _ = q.shape
    n = L // GLA_CHUNK
    f32 = jnp.float32

    def rs(t):
        return t.astype(f32).reshape(B, n, GLA_CHUNK, H, t.shape[-1])

    qc, kc, vc, la = rs(q), rs(k), rs(v), rs(log_a)
    b = jnp.cumsum(la, axis=2)
    b_last = b[:, :, -1:]
    q_dec = qc * jnp.exp(b)
    k_inv = kc * jnp.exp(-b)
    k_end = kc * jnp.exp(b_last - b)
    mask = jnp.tril(jnp.ones((GLA_CHUNK, GLA_CHUNK), f32))
    attn = jnp.einsum('bnihd,bnjhd->bnhij', q_dec, k_inv) * mask
    o_intra = jnp.einsum('bnhij,bnjhe->bnihe', attn, vc)
    u = jnp.einsum('bnjhd,bnjhe->bnhde', k_end, vc)
    decay = jnp.exp(b_last[:, :, 0])

    def step(s, inp):
        dec, uc = inp
        return dec[..., None] * s + uc, s

    _, s_prev = lax.scan(step, s0.astype(f32), (decay.swapaxes(0, 1), u.swapaxes(0, 1)))
    o_inter = jnp.einsum('bnihd,nbhde->bnihe', q_dec, s_prev)
    return (o_intra + o_inter).reshape(B, L, H, v.shape[-1]).astype(v.dtype)


def gla_final_state(k, v, log_a):
    b = jnp.cumsum(log_a.astype(jnp.float32), axis=1)
    w = jnp.exp(b[:, -1:] - b)
    return jnp.einsum('blhd,blhe->bhde', k.astype(jnp.float32) * w, v.astype(jnp.float32))


def flip_seq(t):
    return jnp.flip(t, axis=1)


def gla_bidirectional(g, s_f, s_b):
    o_f = gla_chunked(g['q'], g['k'], g['v'], g['la_f'], s_f)
    o_b = flip_seq(gla_chunked(flip_seq(g['q']), flip_seq(g['k']), flip_seq(g['v']), flip_seq(g['la_b']), s_b))
    return o_f + o_b


def project_heads(h, pos, w_in, w_gla_gate_f, b_gla_gate_f, w_gla_gate_b, b_gla_gate_b,
                  g_mla_qa, w_mla_qb, g_mla_kva, w_mla_kvb, g_gqa_q, g_gqa_k):
    B, L, _ = h.shape
    (gq, gk, gv, gr, glr_f, glr_b, mqa, mkva, mkr, aq, ak, av) = jnp.split(h @ w_in, IN_OFFSETS, axis=-1)
    f32 = jnp.float32
    la_f = jax.nn.log_sigmoid((glr_f @ w_gla_gate_f + b_gla_gate_f).astype(f32)) / GLA_TAU
    la_b = jax.nn.log_sigmoid((glr_b @ w_gla_gate_b + b_gla_gate_b).astype(f32)) / GLA_TAU
    gla = {
        'q': gq.reshape(B, L, GLA_HEADS, GLA_DK) * (GLA_DK ** -0.5),
        'k': gk.reshape(B, L, GLA_HEADS, GLA_DK),
        'v': gv.reshape(B, L, GLA_HEADS, GLA_DV),
        'r': gr,
        'la_f': la_f.reshape(B, L, GLA_HEADS, GLA_DK),
        'la_b': la_b.reshape(B, L, GLA_HEADS, GLA_DK),
    }
    q_m = (rms_norm(mqa, g_mla_qa) @ w_mla_qb).reshape(B, L, MLA_HEADS, MLA_NOPE + MLA_ROPE)
    q_nope, q_rope = q_m[..., :MLA_NOPE], q_m[..., MLA_NOPE:]
    kv_m = (rms_norm(mkva, g_mla_kva) @ w_mla_kvb).reshape(B, L, MLA_HEADS, MLA_NOPE + MLA_DV)
    k_nope, v_m = kv_m[..., :MLA_NOPE], kv_m[..., MLA_NOPE:]
    k_rope = mkr.reshape(B, L, 1, MLA_ROPE)
    q_g = rms_norm(aq.reshape(B, L, GQA_HEADS, GQA_DH), g_gqa_q)
    k_g = rms_norm(ak.reshape(B, L, GQA_KV_HEADS, GQA_DH), g_gqa_k)
    v_g = av.reshape(B, L, GQA_KV_HEADS, GQA_DH)
    if pos is not None:
        row, col = pos
        q_rope = rope_2d(q_rope, row, col)
        k_rope = rope_2d(k_rope, row, col)
        q_g = rope_2d(q_g, row, col)
        k_g = rope_2d(k_g, row, col)
    mla = {
        'q': jnp.concatenate([q_nope, q_rope], axis=-1)[:, :, :, None, :],
        'k': jnp.concatenate([k_nope, jnp.broadcast_to(k_rope, (B, L, MLA_HEADS, MLA_ROPE))], axis=-1),
        'v': v_m,
    }
    gqa = {'q': q_g.reshape(B, L, GQA_KV_HEADS, GQA_GROUP, GQA_DH), 'k': k_g, 'v': v_g}
    return gla, mla, gqa


def merge_heads(o_gla, r, g_gla_norm, o_mla, o_gqa, w_out):
    B, L = o_gla.shape[0], o_gla.shape[1]
    gla = rms_norm(o_gla, g_gla_norm).reshape(B, L, GLA_WIDTH) * jax.nn.silu(r)
    cat = jnp.concatenate([gla, o_mla.reshape(B, L, MLA_WIDTH), o_gqa.reshape(B, L, GQA_WIDTH)], axis=-1)
    return cat @ w_out


def token_mixer(h_lat, h_ctx, pos, w_in, w_gla_gate_f, b_gla_gate_f, w_gla_gate_b, b_gla_gate_b,
                g_gla_norm, g_mla_qa, w_mla_qb, g_mla_kva, w_mla_kvb, g_gqa_q, g_gqa_k, w_out, need_ctx):
    proj = (w_in, w_gla_gate_f, b_gla_gate_f, w_gla_gate_b, b_gla_gate_b,
            g_mla_qa, w_mla_qb, g_mla_kva, w_mla_kvb, g_gqa_q, g_gqa_k)
    gla_l, mla_l, gqa_l = project_heads(h_lat, pos, *proj)
    gla_c, mla_c, gqa_c = project_heads(h_ctx, None, *proj)
    s_f = gla_final_state(gla_c['k'], gla_c['v'], gla_c['la_f'])
    s_b = gla_final_state(flip_seq(gla_c['k']), flip_seq(gla_c['v']), flip_seq(gla_c['la_b']))
    o_gla = gla_bidirectional(gla_l, s_f, s_b)

    def cat(a, b):
        return jnp.concatenate([a, b], axis=1)

    o_mla = blocked_attention(mla_l['q'], cat(mla_c['k'], mla_l['k']), cat(mla_c['v'], mla_l['v']), MLA_SCALE)
    o_gqa = blocked_attention(gqa_l['q'], cat(gqa_c['k'], gqa_l['k']), cat(gqa_c['v'], gqa_l['v']), GQA_SCALE)
    y_lat = merge_heads(o_gla, gla_l['r'], g_gla_norm, o_mla, o_gqa, w_out)
    if not need_ctx:
        return y_lat, None
    zeros = jnp.zeros_like(s_f)
    o_gla_c = gla_bidirectional(gla_c, zeros, zeros)
    o_mla_c = blocked_attention(mla_c['q'], mla_c['k'], mla_c['v'], MLA_SCALE)
    o_gqa_c = blocked_attention(gqa_c['q'], gqa_c['k'], gqa_c['v'], GQA_SCALE)
    y_ctx = merge_heads(o_gla_c, gla_c['r'], g_gla_norm, o_mla_c, o_gqa_c, w_out)
    return y_lat, y_ctx


def expert_choice_ffn(h, w_router, w_gate, w_up, w_down):
    B, n, D = h.shape
    cap = EC_CAPACITY_FACTOR * n // N_EXPERTS
    aff = jax.nn.softmax((h @ w_router).astype(jnp.float32), axis=-1)
    gate, idx = lax.top_k(aff.swapaxes(1, 2), cap)
    xs = jax.vmap(lambda hb, ib: hb[ib])(h, idx)
    hid = jax.nn.silu(jnp.einsum('becd,edf->becf', xs, w_gate)) * jnp.einsum('becd,edf->becf', xs, w_up)
    out = jnp.einsum('becf,efd->becd', hid, w_down) * gate[..., None].astype(h.dtype)
    return jax.vmap(lambda ib, ob: jnp.zeros((n, D), ob.dtype).at[ib.reshape(-1)].add(ob.reshape(-1, D)))(idx, out)


def setup_inputs(seed: int = 0) -> dict:
    key = jax.random.key(seed)
    ks = jax.random.split(key, 32)
    f32 = jnp.float32

    def nrm(i, shape, scale):
        return jax.random.normal(ks[i], shape, f32) * scale

    def gain(i, shape):
        return 1.0 + nrm(i, shape, 0.02)

    return {
        'x': nrm(0, (BATCH, SEQ, D_MODEL), 1.0),
        'c': nrm(1, (BATCH, D_MODEL), 1.0),
        'ctx': nrm(2, (BATCH, CTX_LEN, D_MODEL), 1.0),
        'c_ctx': nrm(3, (D_MODEL,), 1.0),
        'w_mod': nrm(4, (DEPTH, D_MODEL, 6 * D_MODEL), 0.5 * D_MODEL ** -0.5),
        'b_mod': nrm(5, (DEPTH, 6 * D_MODEL), 0.02),
        'w_in': nrm(6, (DEPTH, D_MODEL, IN_WIDTH), D_MODEL ** -0.5),
        'w_gla_gate_f': nrm(7, (DEPTH, GLA_GATE_RANK, GLA_HEADS * GLA_DK), GLA_GATE_RANK ** -0.5),
        'b_gla_gate_f': nrm(8, (DEPTH, GLA_HEADS * GLA_DK), 0.5),
        'w_gla_gate_b': nrm(9, (DEPTH, GLA_GATE_RANK, GLA_HEADS * GLA_DK), GLA_GATE_RANK ** -0.5),
        'b_gla_gate_b': nrm(10, (DEPTH, GLA_HEADS * GLA_DK), 0.5),
        'g_gla_norm': gain(11, (DEPTH, GLA_DV)),
        'g_mla_qa': gain(12, (DEPTH, MLA_Q_RANK)),
        'w_mla_qb': nrm(13, (DEPTH, MLA_Q_RANK, MLA_HEADS * (MLA_NOPE + MLA_ROPE)), MLA_Q_RANK ** -0.5),
        'g_mla_kva': gain(14, (DEPTH, MLA_KV_RANK)),
        'w_mla_kvb': nrm(15, (DEPTH, MLA_KV_RANK, MLA_HEADS * (MLA_NOPE + MLA_DV)), MLA_KV_RANK ** -0.5),
        'g_gqa_q': gain(16, (DEPTH, GQA_DH)),
        'g_gqa_k': gain(17, (DEPTH, GQA_DH)),
        'w_out': nrm(18, (DEPTH, MIX_WIDTH, D_MODEL), DEEPNORM_BETA * MIX_WIDTH ** -0.5),
        'ln1_g': gain(19, (DEPTH, D_MODEL)),
        'ln1_b': nrm(20, (DEPTH, D_MODEL), 0.02),
        'w_router': nrm(21, (DEPTH, D_MODEL, N_EXPERTS), D_MODEL ** -0.5),
        'w_exp_gate': nrm(22, (DEPTH, N_EXPERTS, D_MODEL, D_EXPERT), D_MODEL ** -0.5),
        'w_exp_up': nrm(23, (DEPTH, N_EXPERTS, D_MODEL, D_EXPERT), D_MODEL ** -0.5),
        'w_exp_down': nrm(24, (DEPTH, N_EXPERTS, D_EXPERT, D_MODEL), DEEPNORM_BETA * D_EXPERT ** -0.5),
        'ln2_g': gain(25, (DEPTH, D_MODEL)),
        'ln2_b': nrm(26, (DEPTH, D_MODEL), 0.02),
    }


def reference(x, c, ctx, c_ctx, w_mod, b_mod, w_in, w_gla_gate_f, b_gla_gate_f, w_gla_gate_b, b_gla_gate_b,
              g_gla_norm, g_mla_qa, w_mla_qb, g_mla_kva, w_mla_kvb, g_gqa_q, g_gqa_k, w_out, ln1_g, ln1_b,
              w_router, w_exp_gate, w_exp_up, w_exp_down, ln2_g, ln2_b):
    L = x.shape[1]
    rows = L // GRID_W
    row = jnp.repeat(jnp.arange(rows, dtype=jnp.int32), GRID_W)
    col = jnp.arange(L, dtype=jnp.int32) % GRID_W
    pos = (row, col)
    silu_c = jax.nn.silu(c)
    silu_cc = jax.nn.silu(c_ctx)
    cx = ctx
    for l in range(DEPTH):
        need_ctx = l < DEPTH - 1
        mod = (silu_c @ w_mod[l] + b_mod[l])[:, None, :]
        mod_c = silu_cc @ w_mod[l] + b_mod[l]
        sh1, sc1, g1, sh2, sc2, g2 = jnp.split(mod, 6, axis=-1)
        csh1, csc1, cg1, csh2, csc2, cg2 = jnp.split(mod_c, 6, axis=-1)
        h_lat = x * (1.0 + sc1) + sh1
        h_ctx = cx * (1.0 + csc1) + csh1
        a_lat, a_ctx = token_mixer(h_lat, h_ctx, pos, w_in[l], w_gla_gate_f[l], b_gla_gate_f[l],
                                   w_gla_gate_b[l], b_gla_gate_b[l], g_gla_norm[l], g_mla_qa[l], w_mla_qb[l],
                                   g_mla_kva[l], w_mla_kvb[l], g_gqa_q[l], g_gqa_k[l], w_out[l], need_ctx)
        x = layer_norm(DEEPNORM_ALPHA * x + g1 * a_lat, ln1_g[l], ln1_b[l])
        f_lat = expert_choice_ffn(x * (1.0 + sc2) + sh2, w_router[l], w_exp_gate[l], w_exp_up[l], w_exp_down[l])
        x = layer_norm(DEEPNORM_ALPHA * x + g2 * f_lat, ln2_g[l], ln2_b[l])
        if need_ctx:
            cx = layer_norm(DEEPNORM_ALPHA * cx + cg1 * a_ctx, ln1_g[l], ln1_b[l])
            f_ctx = expert_choice_ffn(cx * (1.0 + csc2) + csh2, w_router[l], w_exp_gate[l], w_exp_up[l], w_exp_down[l])
            cx = layer_norm(DEEPNORM_ALPHA * cx + cg2 * f_ctx, ln2_g[l], ln2_b[l])
    return x
```

```cpp
#include <hip/hip_runtime.h>
#include <hip/hip_cooperative_groups.h>
#include <cstdio>
namespace cg = cooperative_groups;

#ifndef MULTI_LAUNCH
#define MULTI_LAUNCH 0
#endif
#ifndef PROBE
#define PROBE 0
#endif
#define DBL_D 0
#define DBL_I 0
#define DBL_A 0
#define DBL_E 0
#define DBL_B 0
#define DBL_0 0
#define ALLWAVE_WB 1
#define BAR_DELAY 0
#define PROBE_PH 1000
#define PROBE_OFF OFF_EOUT
#define PROBE_WORDS ((size_t)NROWS_E * 512)
#define XSYNC 0
#define DBL_G 0
#define DBL_H 0
#ifndef STOP_PHASE
#define STOP_PHASE 100
#endif

typedef unsigned short bf16_t;
using bf16x8 = __attribute__((ext_vector_type(8))) short;
using f32x4 = __attribute__((ext_vector_type(4))) float;
using u32x4 = __attribute__((ext_vector_type(4))) unsigned;
#define DI __device__ __forceinline__
#define MFMA16(a, b, c) __builtin_amdgcn_mfma_f32_16x16x32_bf16((a), (b), (c), 0, 0, 0)

constexpr int NL = 16384;
constexpr int NC = 512;
constexpr int NT = NL + NC;
constexpr int DM = 1024;
constexpr int INW = 2112;
constexpr int LK = 8448;
constexpr int NROWS_E = 32768 + 512;
constexpr float ALPHA = 1.681792830507429f;
constexpr float LOG2E = 1.4426950408889634f;
constexpr float MLA_QS = 0.10206207261596577f * LOG2E;
constexpr float GQA_QS = 0.125f * LOG2E;
constexpr float GLA_QS = 0.17677669529663687f;
constexpr float LOG2_THETA = 13.287712379549449f;

constexpr int C_GQ = 0, C_GK = 128, C_GV = 256, C_GR = 512, C_GLRF = 768, C_MQA = 800, C_MKVA = 1184, C_MKR = 1440,
              C_AQ = 1472, C_AK = 1856, C_AV = 1984;

constexpr size_t al256(size_t x) { return (x + 255) & ~size_t(255); }
constexpr size_t OFF_MOD = 0;
constexpr size_t OFF_XF = OFF_MOD + al256((size_t)4 * 3 * 6144 * 4);
constexpr size_t OFF_HB = OFF_XF + al256((size_t)NT * DM * 4);
constexpr size_t OFF_CAT = OFF_HB + al256((size_t)NT * DM * 2);
constexpr size_t OFF_Y = OFF_CAT + al256((size_t)NT * DM * 2);
constexpr size_t OFF_PJ = OFF_Y + al256((size_t)NT * DM * 4);
constexpr size_t OFF_QM = OFF_PJ + al256((size_t)NT * INW * 2);
constexpr size_t OFF_KVM = OFF_QM + al256((size_t)NT * 576 * 2);
constexpr size_t OFF_KR = OFF_KVM + al256((size_t)NT * 768 * 2);
constexpr size_t OFF_QG = OFF_KR + al256((size_t)NT * 32 * 2);
constexpr size_t OFF_KG = OFF_QG + al256((size_t)NT * 384 * 2);
constexpr size_t OFF_VTM = OFF_KG + al256((size_t)NT * 128 * 2);
constexpr size_t OFF_VTG = OFF_VTM + al256((size_t)2 * 6 * 64 * LK * 2);
constexpr size_t OFF_U = OFF_VTG + al256((size_t)2 * 2 * 64 * LK * 2);
constexpr size_t OFF_SP = OFF_U + al256((size_t)2112 * 2048 * 4);
constexpr size_t OFF_DEC = OFF_SP + al256((size_t)2112 * 2048 * 4);
constexpr size_t OFF_HID = OFF_DEC + al256((size_t)2112 * 32 * 4);
constexpr size_t OFF_EOUT = OFF_HID + al256((size_t)NROWS_E * DM * 2);
constexpr size_t OFF_AFFT = OFF_EOUT + al256((size_t)NROWS_E * DM * 2);
constexpr size_t OFF_SEL = OFF_AFFT + al256((size_t)16 * NT * 4);
constexpr size_t OFF_ROWTOK = OFF_SEL + al256((size_t)16 * NT * 4);
constexpr size_t OFF_GATEV = OFF_ROWTOK + al256((size_t)NROWS_E * 4);
constexpr size_t OFF_WIN = OFF_GATEV + al256((size_t)NROWS_E * 4);
constexpr size_t OFF_WQB = OFF_WIN + al256((size_t)4 * 2176 * 1024 * 2);
constexpr size_t OFF_WKVB = OFF_WQB + al256((size_t)4 * 640 * 384 * 2);
constexpr size_t OFF_WOUT = OFF_WKVB + al256((size_t)4 * 768 * 256 * 2);
constexpr size_t OFF_WGU = OFF_WOUT + al256((size_t)4 * 1024 * 1024 * 2);
constexpr size_t OFF_WD = OFF_WGU + al256((size_t)64 * 2048 * 1024 * 2);
constexpr size_t WS_END = OFF_WD + al256((size_t)64 * 1024 * 1024 * 2);

constexpr size_t OFF_BAR = WS_END;
constexpr size_t OFF_TAB = WS_END + 16384;
constexpr size_t WS_TOTAL = OFF_TAB + 32768;
constexpr int SMEM_BYTES = 59392;

struct Params {
  const float *x, *c, *ctx, *c_ctx, *w_mod, *b_mod, *w_in, *w_gf, *b_gf, *w_gb, *b_gb, *g_gla, *g_qa, *w_qb, *g_kva, *w_kvb,
      *g_gq, *g_gk, *w_out, *ln1_g, *ln1_b, *w_router, *w_eg, *w_eu, *w_ed, *ln2_g, *ln2_b;
  float* out;
  char* ws;
};

DI int otid() { int t = threadIdx.x; asm volatile("" : "+v"(t)); return t; }
DI int obid() { int t = __builtin_amdgcn_workgroup_id_x(); asm volatile("" : "+s"(t)); return t; }
DI bf16_t f2bf(float f) { unsigned u = __float_as_uint(f); u += 0x7fffu + ((u >> 16) & 1u); return (bf16_t)(u >> 16); }
DI float bf2f(bf16_t b) { return __uint_as_float(((unsigned)b) << 16); }
typedef __bf16 hbf16x2 __attribute__((ext_vector_type(2)));
typedef float f32x2 __attribute__((ext_vector_type(2)));
DI unsigned pack2(float a, float b) { f32x2 v = {a, b}; return __builtin_bit_cast(unsigned, __builtin_convertvector(v, hbf16x2)); }
DI float wave_sum(float v) {
#pragma unroll
  for (int o = 32; o > 0; o >>= 1) v += __shfl_xor(v, o);
  return v;
}
DI float siluf(float x) { return x / (1.f + __expf(-x)); }
DI float logsigf(float z) { return fminf(z, 0.f) - log1pf(__expf(-fabsf(z))); }
DI int tok_set(int tok) { return tok < NL ? (tok >> 13) : 2; }
DI void tok_bp(int tok, int& b, int& pp) {
  if (tok < NL) { b = tok >> 13; pp = 256 + (tok & 8191); }
  else { int t = tok - NL; b = t >> 8; pp = t & 255; }
}

template <class Epi>
DI void gemm_tile(unsigned* g_badcnt, const bf16_t* __restrict__ A, int lda, const int* __restrict__ rowidx, int row0, int nvalid,
                  const bf16_t* __restrict__ Bt, int ldb, int K, bf16_t* smem, Epi epi) {
  const int tid = otid(), lane = tid & 63, wave = tid >> 6;
  const int wm = wave >> 1, wn = wave & 1;
  bf16_t* As = smem;
  bf16_t* Bs = smem + 128 * 72;
  const int lr = tid >> 3, lc = (tid & 7) * 8;
  const bf16_t* ap[4];
  const bf16_t* bp[4];
#pragma unroll
  for (int j = 0; j < 4; ++j) {
    int r = lr + 32 * j;
    int rr = r < nvalid ? r : 0;
    long grow = rowidx ? (long)rowidx[row0 + rr] : (long)(row0 + rr);
    if (rowidx) { if (grow < 0 || grow >= NT) grow = 0; }
    ap[j] = A + grow * lda + lc;
    bp[j] = Bt + (long)r * ldb + lc;
  }
  u32x4 raA[4], rbA[4], raB[4], rbB[4];
  const int nk = K >> 6;
#pragma unroll
  for (int j = 0; j < 4; ++j) { raA[j] = *(const u32x4*)ap[j]; rbA[j] = *(const u32x4*)bp[j]; }
  if (nk > 1) {
#pragma unroll
    for (int j = 0; j < 4; ++j) { raB[j] = *(const u32x4*)(ap[j] + 64); rbB[j] = *(const u32x4*)(bp[j] + 64); }
  }
  f32x4 acc[4][4];
#pragma unroll
  for (int a = 0; a < 4; ++a)
#pragma unroll
    for (int b = 0; b < 4; ++b) acc[a][b] = f32x4{0.f, 0.f, 0.f, 0.f};
  const int l15 = lane & 15, lg = lane >> 4;
  auto stage_and_compute = [&](u32x4 (&ra)[4], u32x4 (&rb)[4], int knext) {
    __syncthreads();
#pragma unroll
    for (int j = 0; j < 4; ++j) {
      *(u32x4*)(As + (lr + 32 * j) * 72 + lc) = ra[j];
      *(u32x4*)(Bs + (lr + 32 * j) * 72 + lc) = rb[j];
    }
    __syncthreads();
    if (knext < nk) {
#pragma unroll
      for (int j = 0; j < 4; ++j) { ra[j] = *(const u32x4*)(ap[j] + knext * 64); rb[j] = *(const u32x4*)(bp[j] + knext * 64); }
    }
    __builtin_amdgcn_sched_barrier(0);
#pragma unroll
    for (int ks = 0; ks < 2; ++ks) {
      bf16x8 af[4], wf[4];
#pragma unroll
      for (int mi = 0; mi < 4; ++mi) af[mi] = *(const bf16x8*)(As + (wm * 64 + mi * 16 + l15) * 72 + ks * 32 + lg * 8);
#pragma unroll
      for (int ni = 0; ni < 4; ++ni) wf[ni] = *(const bf16x8*)(Bs + (wn * 64 + ni * 16 + l15) * 72 + ks * 32 + lg * 8);
#pragma unroll
      for (int ni = 0; ni < 4; ++ni)
#pragma unroll
        for (int mi = 0; mi < 4; ++mi) acc[ni][mi] = MFMA16(wf[ni], af[mi], acc[ni][mi]);
    }
  };
  for (int kt = 0; kt < nk; kt += 2) {
    stage_and_compute(raA, rbA, kt + 2);
    if (kt + 1 >= nk) break;
    stage_and_compute(raB, rbB, kt + 3);
  }
  epi(acc, wm, wn, lane);
}

DI void tile_rowscale(const bf16_t* __restrict__ A, int lda, int row0, int ncols, float* rs) {
  const int tid = otid();
  const int r = tid >> 1, half = tid & 1;
  const int nh = ncols >> 1;
  const bf16_t* src = A + (long)(row0 + r) * lda + half * nh;
  float s = 0.f;
  for (int c = 0; c < nh; c += 8) {
    uint4 v = *(const uint4*)(src + c);
    unsigned w[4] = {v.x, v.y, v.z, v.w};
#pragma unroll
    for (int q = 0; q < 4; ++q) {
      float a = __uint_as_float(w[q] << 16), b = __uint_as_float(w[q] & 0xffff0000u);
      s += a * a + b * b;
    }
  }
  s += __shfl_xor(s, 1);
  if (half == 0) rs[r] = rsqrtf(s / (float)ncols + 1e-6f);
}

struct ConvDesc { const float* src; bf16_t* dst; const float* gs; int K, N, k0, n0, mode; };

DI ConvDesc conv_decode(const Params& p, int i) {
  bf16_t* WIN = (bf16_t*)(p.ws + OFF_WIN);
  bf16_t* WQB = (bf16_t*)(p.ws + OFF_WQB);
  bf16_t* WKVB = (bf16_t*)(p.ws + OFF_WKVB);
  bf16_t* WOUT = (bf16_t*)(p.ws + OFF_WOUT);
  bf16_t* WGU = (bf16_t*)(p.ws + OFF_WGU);
  bf16_t* WD = (bf16_t*)(p.ws + OFF_WD);
  ConvDesc d;
  d.gs = nullptr; d.mode = 0;
  if (i < 2176) { int l = i / 544, r = i % 544; d.src = p.w_in + (size_t)l * 1024 * INW; d.K = 1024; d.N = INW; d.k0 = (r / 34) * 64; d.n0 = (r % 34) * 64; d.dst = WIN + (size_t)l * 2176 * 1024; return d; }
  i -= 2176;
  if (i < 240) { int l = i / 60, r = i % 60; d.src = p.w_qb + (size_t)l * 384 * 576; d.K = 384; d.N = 576; d.k0 = (r / 10) * 64; d.n0 = (r % 10) * 64; d.dst = WQB + (size_t)l * 640 * 384; d.gs = p.g_qa + l * 384; return d; }
  i -= 240;
  if (i < 192) { int l = i / 48, r = i % 48; d.src = p.w_kvb + (size_t)l * 256 * 768; d.K = 256; d.N = 768; d.k0 = (r / 12) * 64; d.n0 = (r % 12) * 64; d.dst = WKVB + (size_t)l * 768 * 256; d.gs = p.g_kva + l * 256; return d; }
  i -= 192;
  if (i < 1024) { int l = i / 256, r = i % 256; d.src = p.w_out + (size_t)l * 1048576; d.K = 1024; d.N = 1024; d.k0 = (r / 16) * 64; d.n0 = (r % 16) * 64; d.dst = WOUT + (size_t)l * 1048576; return d; }
  i -= 1024;
  const int which = i / 16384, ii = i % 16384;
  const int m = ii / 256, r = ii % 256;
  d.K = 1024; d.N = 1024; d.k0 = (r / 16) * 64; d.n0 = (r % 16) * 64;
  if (which == 0) { d.src = p.w_eg + (size_t)m * 1048576; d.dst = WGU + (size_t)m * 2097152; d.mode = 1; }
  else if (which == 1) { d.src = p.w_eu + (size_t)m * 1048576; d.dst = WGU + (size_t)m * 2097152; d.mode = 2; }
  else { d.src = p.w_ed + (size_t)m * 1048576; d.dst = WD + (size_t)m * 1048576; }
  return d;
}

DI void conv_load(const ConvDesc& d, int tid, f32x4 (&v)[4], float (&sc)[4]) {
  const int c4 = (tid & 15) * 4;
#pragma unroll
  for (int j = 0; j < 4; ++j) {
    const int r = (tid >> 4) + 16 * j;
    v[j] = f32x4{0.f, 0.f, 0.f, 0.f};
    if (d.n0 + c4 < d.N) v[j] = *(const f32x4*)(d.src + (size_t)(d.k0 + r) * d.N + d.n0 + c4);
    sc[j] = d.gs ? d.gs[d.k0 + r] : 1.f;
  }
}

DI void conv_store(const ConvDesc& d, int tid, const f32x4 (&v)[4], const float (&sc)[4], float* sm) {
  __syncthreads();
  const int c4 = (tid & 15) * 4;
#pragma unroll
  for (int j = 0; j < 4; ++j) {
    const int r = (tid >> 4) + 16 * j;
    sm[r * 65 + c4 + 0] = v[j][0] * sc[j];
    sm[r * 65 + c4 + 1] = v[j][1] * sc[j];
    sm[r * 65 + c4 + 2] = v[j][2] * sc[j];
    sm[r * 65 + c4 + 3] = v[j][3] * sc[j];
  }
  __syncthreads();
  const int n = tid >> 2, ks = (tid & 3) * 16;
  unsigned w[8];
#pragma unroll
  for (int q = 0; q < 8; ++q) w[q] = pack2(sm[(ks + 2 * q) * 65 + n], sm[(ks + 2 * q + 1) * 65 + n]);
  const int gn = d.n0 + n;
  int drow = gn;
  if (d.mode != 0) drow = (gn >> 5) * 64 + (gn & 31) + (d.mode == 2 ? 32 : 0);
  uint4* dp = (uint4*)(d.dst + (size_t)drow * d.K + d.k0 + ks);
  dp[0] = make_uint4(w[0], w[1], w[2], w[3]);
  dp[1] = make_uint4(w[4], w[5], w[6], w[7]);
}

DI void phase0(const Params& p, char* smem) {
  float* sm = (float*)smem;
  float* MOD = (float*)(p.ws + OFF_MOD);
  const int NCONV = 2176 + 240 + 192 + 1024 + 3 * 16384;
  const int tid = otid();
  const int G = gridDim.x;
  {
    int it = obid();
    f32x4 v[4]; float sc[4];
    ConvDesc cur = conv_decode(p, it < NCONV ? it : 0);
    if (it < NCONV) conv_load(cur, tid, v, sc);
    while (it < NCONV) {
      const int nxt = it + G;
      f32x4 vn[4]; float scn[4];
      ConvDesc dn = conv_decode(p, nxt < NCONV ? nxt : 0);
      if (nxt < NCONV) conv_load(dn, tid, vn, scn);
      conv_store(cur, tid, v, sc, sm);
#pragma unroll
      for (int j = 0; j < 4; ++j) { v[j] = vn[j]; sc[j] = scn[j]; }
      cur = dn;
      it = nxt;
    }
  }
  for (int i = obid(); i < 385; i += G) {
    if (i >= 384) {
      float* TAB = (float*)(p.ws + OFF_TAB);
      for (int q = tid; q < 128 * 24; q += 256) {
        const int pos = q / 24, f = q % 24;
        const float invf = f < 16 ? exp2f(-(float)f * (LOG2_THETA / 16.f)) : exp2f(-(float)(f - 16) * (LOG2_THETA / 8.f));
        const float ang = (float)pos * invf;
        TAB[q * 2] = cosf(ang);
        TAB[q * 2 + 1] = sinf(ang);
      }
      continue;
    }
    {
      const int l = i / 96, n0 = (i % 96) * 64;
      const int lane = tid & 63, wave = tid >> 6;
      __syncthreads();
      for (int k = tid; k < 3072; k += 256) {
        int s = k >> 10, kk = k & 1023;
        float cv = s < 2 ? p.c[s * 1024 + kk] : p.c_ctx[kk];
        sm[k] = cv / (1.f + expf(-cv));
      }
      __syncthreads();
      float a0 = 0.f, a1 = 0.f, a2 = 0.f;
      const float* w = p.w_mod + (size_t)l * 1024 * 6144 + n0 + lane;
#pragma unroll 8
      for (int k = wave * 256; k < wave * 256 + 256; ++k) {
        float wv = w[(size_t)k * 6144];
        a0 += sm[k] * wv; a1 += sm[1024 + k] * wv; a2 += sm[2048 + k] * wv;
      }
      float* part = sm + 3072;
      part[(wave * 3 + 0) * 64 + lane] = a0;
      part[(wave * 3 + 1) * 64 + lane] = a1;
      part[(wave * 3 + 2) * 64 + lane] = a2;
      __syncthreads();
      if (tid < 192) {
        int s = tid >> 6, ln = tid & 63;
        float v2 = part[(0 * 3 + s) * 64 + ln] + part[(1 * 3 + s) * 64 + ln] + part[(2 * 3 + s) * 64 + ln] + part[(3 * 3 + s) * 64 + ln];
        MOD[(size_t)(l * 3 + s) * 6144 + n0 + ln] = v2 + p.b_mod[l * 6144 + n0 + ln];
      }
    }
  }
}

DI void phase0b(const Params& p) {
  float* XF = (float*)(p.ws + OFF_XF);
  bf16_t* HB = (bf16_t*)(p.ws + OFF_HB);
  const float* MOD = (const float*)(p.ws + OFF_MOD);
  const int total = NT * 256;
  for (int idx = obid() * 256 + otid(); idx < total; idx += gridDim.x * 256) {
    int tok = idx >> 8, c = (idx & 255) * 4;
    const float* src = tok < NL ? p.x + (size_t)tok * 1024 : p.ctx + (size_t)(tok - NL) * 1024;
    float4 v = *(const float4*)(src + c);
    *(float4*)(XF + (size_t)tok * 1024 + c) = v;
    const float* md = MOD + (size_t)tok_set(tok) * 6144;
    float4 sh = *(const float4*)(md + c), sc = *(const float4*)(md + 1024 + c);
    uint2 o;
    o.x = pack2(v.x * (1.f + sc.x) + sh.x, v.y * (1.f + sc.y) + sh.y);
    o.y = pack2(v.z * (1.f + sc.z) + sh.z, v.w * (1.f + sc.w) + sh.w);
    *(uint2*)(HB + (size_t)tok * 1024 + c) = o;
  }
}

DI void phaseA(const Params& p, int l, char* smem) {
  const bf16_t* HB = (const bf16_t*)(p.ws + OFF_HB);
  const bf16_t* WIN = (const bf16_t*)(p.ws + OFF_WIN) + (size_t)l * 2176 * 1024;
  bf16_t* PJ = (bf16_t*)(p.ws + OFF_PJ);
  const int ntiles = 132 * 17;
  const int bid_ = obid();
  const bool xmap = (gridDim.x == 512);
  const int xn = xmap ? ((132 - (bid_ & 7) + 7) >> 3) * 17 : 0;
  for (int t_ = xmap ? (bid_ >> 3) : bid_; t_ < (xmap ? xn : ntiles); t_ += (xmap ? 64 : (int)gridDim.x)) {
    const int mt = xmap ? (bid_ & 7) + 8 * (t_ / 17) : t_ / 17, nt = t_ % 17;
    gemm_tile((unsigned*)(p.ws + OFF_Y) + 8, HB, 1024, nullptr, mt * 128, 128, WIN + (size_t)nt * 128 * 1024, 1024, 1024, (bf16_t*)smem,
              [&](f32x4 (&acc)[4][4], int wm, int wn, int lane) {
#pragma unroll
                for (int ni = 0; ni < 4; ++ni) {
                  int n = nt * 128 + wn * 64 + ni * 16 + (lane >> 4) * 4;
                  if (n < INW) {
#pragma unroll
                    for (int mi = 0; mi < 4; ++mi) {
                      int m = mt * 128 + wm * 64 + mi * 16 + (lane & 15);
                      uint2 o;
                      o.x = pack2(acc[ni][mi][0], acc[ni][mi][1]);
                      o.y = pack2(acc[ni][mi][2], acc[ni][mi][3]);
                      *(uint2*)(PJ + (size_t)m * INW + n) = o;
                    }
                  }
                }
              });
  }
}

DI void gla_la8(const bf16_t* __restrict__ PJ, int tok, int dir, const float* __restrict__ W, const float* __restrict__ bias, int h, int d0,
                float* out8) {
  const bf16_t* g = PJ + (size_t)tok * INW + C_GLRF + dir * 16;
  uint4 g0 = *(const uint4*)g, g1 = *(const uint4*)(g + 8);
  unsigned gw[8] = {g0.x, g0.y, g0.z, g0.w, g1.x, g1.y, g1.z, g1.w};
  float a[8];
#pragma unroll
  for (int q = 0; q < 8; ++q) a[q] = bias[d0 + q];
#pragma unroll
  for (int r = 0; r < 16; ++r) {
    float gv = (r & 1) ? __uint_as_float(gw[r >> 1] & 0xffff0000u) : __uint_as_float(gw[r >> 1] << 16);
    const float* wr = W + r * 32 + d0;
#pragma unroll
    for (int q = 0; q < 8; ++q) a[q] += gv * wr[q];
  }
#pragma unroll
  for (int q = 0; q < 8; ++q) out8[q] = logsigf(a[q]) * (1.f / 16.f);
}

DI void gla_cumsum(const bf16_t* __restrict__ PJ, int tok0, int dir, const float* __restrict__ W, const float* __restrict__ bias, int h,
                   float* la, float* blast, float* segtot) {
  const int tid = otid();
  float* wl = segtot + 256;
  {
    const int r = tid >> 4, c = (tid & 15) * 2;
    wl[r * 32 + c] = W[r * 128 + h * 32 + c];
    wl[r * 32 + c + 1] = W[r * 128 + h * 32 + c + 1];
    if (tid < 32) wl[512 + tid] = bias[h * 32 + tid];
  }
  __syncthreads();
  {
    const int t = tid >> 2, d0 = (tid & 3) * 8;
    float o8[8];
    gla_la8(PJ, tok0 + t, dir, wl, wl + 512, h, d0, o8);
#pragma unroll
    for (int q = 0; q < 8; ++q) la[t * 32 + d0 + q] = o8[q];
  }
  __syncthreads();
  const int d = tid & 31, seg = tid >> 5;
  float vals[8];
  float run = 0.f;
#pragma unroll
  for (int k = 0; k < 8; ++k) {
    const int o = seg * 8 + k;
    const int t = dir ? 63 - o : o;
    run += la[t * 32 + d];
    vals[k] = run;
  }
  segtot[seg * 32 + d] = run;
  __syncthreads();
  float off = 0.f;
#pragma unroll
  for (int sgi = 0; sgi < 7; ++sgi) off += (sgi < seg) ? segtot[sgi * 32 + d] : 0.f;
#pragma unroll
  for (int k = 0; k < 8; ++k) {
    const int o = seg * 8 + k;
    const int t = dir ? 63 - o : o;
    la[t * 32 + d] = vals[k] + off;
  }
  if (seg == 7) blast[d] = run + off;
  __syncthreads();
}

DI int chunk_tok0(int cidx) { return cidx < 256 ? cidx * 64 : NL + (cidx - 256) * 64; }

DI void gla_u_item(const Params& p, int l, int item, char* smem) {
  const bf16_t* PJ = (const bf16_t*)(p.ws + OFF_PJ);
  float* U = (float*)(p.ws + OFF_U);
  float* DEC = (float*)(p.ws + OFF_DEC);
  const int dir = item & 1, h = (item >> 1) & 3, cidx = item >> 3;
  const int tok0 = chunk_tok0(cidx);
  const float* W = (dir ? p.w_gb : p.w_gf) + l * 16 * 128;
  const float* bias = (dir ? p.b_gb : p.b_gf) + l * 128;
  float* la = (float*)smem;
  float* blast = la + 2048;
  float* segtot = blast + 32;
  bf16_t* VT = (bf16_t*)(segtot + 256 + 544);
  bf16_t* KT = VT + 64 * 72;
  const int tid = otid(), lane = tid & 63, wave = tid >> 6;
  const int l15 = lane & 15, lg = lane >> 4;
  __syncthreads();
  gla_cumsum(PJ, tok0, dir, W, bias, h, la, blast, segtot);
  {
    const int t = tid >> 2, d0 = (tid & 3) * 8;
    const bf16_t* kp = PJ + (size_t)(tok0 + t) * INW + C_GK + h * 32 + d0;
    const u32x4 kr = *(const u32x4*)kp;
#pragma unroll
    for (int q = 0; q < 8; ++q) {
      const unsigned wd = kr[q >> 1];
      const float kv = (q & 1) ? __uint_as_float(wd & 0xffff0000u) : __uint_as_float(wd << 16);
      KT[(d0 + q) * 72 + t] = f2bf(kv * __expf(blast[d0 + q] - la[t * 32 + d0 + q]));
    }
    const int e0 = (tid & 3) * 16;
    const bf16_t* vp = PJ + (size_t)(tok0 + t) * INW + C_GV + h * 64 + e0;
    const u32x4 v0 = *(const u32x4*)vp, v1 = *(const u32x4*)(vp + 8);
#pragma unroll
    for (int q = 0; q < 8; ++q) {
      const unsigned w0 = v0[q >> 1], w1 = v1[q >> 1];
      VT[(e0 + q) * 72 + t] = (bf16_t)((q & 1) ? (w0 >> 16) : (w0 & 0xffffu));
      VT[(e0 + 8 + q) * 72 + t] = (bf16_t)((q & 1) ? (w1 >> 16) : (w1 & 0xffffu));
    }
  }
  __syncthreads();
  f32x4 acc[2] = {f32x4{0.f, 0.f, 0.f, 0.f}, f32x4{0.f, 0.f, 0.f, 0.f}};
#pragma unroll
  for (int s2 = 0; s2 < 2; ++s2) {
    const bf16x8 vf = *(const bf16x8*)(VT + (wave * 16 + l15) * 72 + s2 * 32 + lg * 8);
#pragma unroll
    for (int dt = 0; dt < 2; ++dt) {
      const bf16x8 kf = *(const bf16x8*)(KT + (dt * 16 + l15) * 72 + s2 * 32 + lg * 8);
      acc[dt] = MFMA16(vf, kf, acc[dt]);
    }
  }
#pragma unroll
  for (int dt = 0; dt < 2; ++dt) {
    float* up = U + (size_t)item * 2048 + (dt * 16 + l15) * 64 + wave * 16 + lg * 4;
    *(float4*)up = make_float4(acc[dt][0], acc[dt][1], acc[dt][2], acc[dt][3]);
  }
  if (tid < 32) DEC[item * 32 + tid] = __expf(blast[tid]);
}

DI void prep_item(const Params& p, int l, int tile, char* smem) {
  const bf16_t* PJ = (const bf16_t*)(p.ws + OFF_PJ);
  bf16_t* QG = (bf16_t*)(p.ws + OFF_QG);
  bf16_t* KG = (bf16_t*)(p.ws + OFF_KG);
  bf16_t* KR = (bf16_t*)(p.ws + OFF_KR);
  bf16_t* VTG = (bf16_t*)(p.ws + OFF_VTG);
  const float* TAB = (const float*)(p.ws + OFF_TAB);
  const int tok0 = tile * 64;
  const int tid = otid(), lane = tid & 63, wave = tid >> 6;
  const bool lat = tok0 < NL;
  __syncthreads();
  for (int tt = wave; tt < 64; tt += 4) {
    const int tok = tok0 + tt;
    const bf16_t* row = PJ + (size_t)tok * INW;
    float v[8];
#pragma unroll
    for (int hh = 0; hh < 8; ++hh) v[hh] = bf2f(row[(hh < 6 ? C_AQ + hh * 64 : C_AK + (hh - 6) * 64) + lane]);
    float kr = bf2f(row[C_MKR + (lane & 31)]);
    const int t = tok & 8191;
    float csg = 1.f, sng = 0.f, csm = 1.f, snm = 0.f;
    if (lat) {
      const float2 a = *(const float2*)(TAB + ((lane < 32 ? (t >> 6) : (t & 63)) * 24 + (lane & 15)) * 2);
      csg = a.x; sng = a.y;
      const int r = lane & 31;
      const float2 m2 = *(const float2*)(TAB + (((r >> 4) ? (t & 63) : (t >> 6)) * 24 + 16 + (r & 7)) * 2);
      csm = m2.x; snm = m2.y;
    }
    const float gq = p.g_gq[l * 64 + lane], gk = p.g_gk[l * 64 + lane];
#pragma unroll
    for (int hh = 0; hh < 8; ++hh) {
      const float ss = wave_sum(v[hh] * v[hh]);
      const float rn = rsqrtf(ss * (1.f / 64.f) + 1e-6f);
      float y = v[hh] * rn * (hh < 6 ? gq : gk);
      const float partner = __shfl_xor(y, 16);
      y = ((lane >> 4) & 1) ? (partner * sng + y * csg) : (y * csg - partner * sng);
      if (hh < 6) QG[(size_t)tok * 384 + hh * 64 + lane] = f2bf(y * GQA_QS);
      else KG[(size_t)tok * 128 + (hh - 6) * 64 + lane] = f2bf(y);
    }
    {
      const float partner = __shfl_xor(kr, 8);
      const int r = lane & 31;
      kr = ((r >> 3) & 1) ? (partner * snm + kr * csm) : (kr * csm - partner * snm);
      if (lane < 32) KR[(size_t)tok * 32 + r] = f2bf(kr);
    }
  }
  bf16_t* sm = (bf16_t*)smem;
  for (int c = tid; c < 64 * 16; c += 256) {
    int t = c >> 4, cc = (c & 15) * 8;
    *(uint4*)(sm + t * 136 + cc) = *(const uint4*)(PJ + (size_t)(tok0 + t) * INW + C_AV + cc);
  }
  __syncthreads();
  {
    int b, pp;
    tok_bp(tok0, b, pp);
    const int c = tid >> 1, half = tid & 1;
    const int kvh = c >> 6, dv = c & 63;
    unsigned w[16];
#pragma unroll
    for (int q = 0; q < 16; ++q) {
      unsigned lo = sm[(half * 32 + 2 * q) * 136 + c], hi = sm[(half * 32 + 2 * q + 1) * 136 + c];
      w[q] = lo | (hi << 16);
    }
    uint4* d = (uint4*)(VTG + ((size_t)((b * 2 + kvh) * 64 + dv)) * LK + pp + half * 32);
    d[0] = make_uint4(w[0], w[1], w[2], w[3]);
    d[1] = make_uint4(w[4], w[5], w[6], w[7]);
    d[2] = make_uint4(w[8], w[9], w[10], w[11]);
    d[3] = make_uint4(w[12], w[13], w[14], w[15]);
  }
}

DI void phaseB(const Params& p, int l, char* smem) {
  const bf16_t* PJ = (const bf16_t*)(p.ws + OFF_PJ);
  const bf16_t* WQB = (const bf16_t*)(p.ws + OFF_WQB) + (size_t)l * 640 * 384;
  const bf16_t* WKVB = (const bf16_t*)(p.ws + OFF_WKVB) + (size_t)l * 768 * 256;
  bf16_t* QM = (bf16_t*)(p.ws + OFF_QM);
  bf16_t* KVM = (bf16_t*)(p.ws + OFF_KVM);
  bf16_t* VTM = (bf16_t*)(p.ws + OFF_VTM);
  float* rs = (float*)(smem + 2 * 128 * 72 * 2);
  const float* TAB = (const float*)(p.ws + OFF_TAB);
  const int N_G2 = 132 * 5, N_G3 = 132 * 6, N_PREP = 264, N_U = 2112;
  const int total = N_G2 + N_G3 + N_PREP + N_U;
  for (int it = obid(); it < total; it += gridDim.x) {
    int id = it;
    if (id < N_G2) {
      const int mt = id / 5, nt = id % 5;
      __syncthreads();
      tile_rowscale(PJ + C_MQA, INW, mt * 128, 384, rs);
      gemm_tile((unsigned*)(p.ws + OFF_Y) + 8, PJ + C_MQA, INW, nullptr, mt * 128, 128, WQB + (size_t)nt * 128 * 384, 384, 384, (bf16_t*)smem,
                [&](f32x4 (&acc)[4][4], int wm, int wn, int lane) {
#pragma unroll
                  for (int ni = 0; ni < 4; ++ni) {
                    const int n = nt * 128 + wn * 64 + ni * 16 + (lane >> 4) * 4;
                    const int d = n % 96;
#pragma unroll
                    for (int mi = 0; mi < 4; ++mi) {
                      const int ml = wm * 64 + mi * 16 + (lane & 15);
                      const int tok = mt * 128 + ml;
                      const float rsc = rs[ml];
                      float v[4], pr[4];
#pragma unroll
                      for (int i = 0; i < 4; ++i) { v[i] = acc[ni][mi][i] * rsc; pr[i] = __shfl_xor(v[i], 32); }
                      if (d >= 64 && tok < NL && n < 576) {
                        const int r = d - 64;
                        const int t = tok & 8191;
                        const int pos = (r >> 4) ? (t & 63) : (t >> 6);
                        const bool second = (r >> 3) & 1;
                        const float* tb = TAB + (pos * 24 + 16 + (r & 7)) * 2;
                        const float4 c01 = *(const float4*)tb, c23 = *(const float4*)(tb + 4);
                        const float csv[4] = {c01.x, c01.z, c23.x, c23.z}, snv[4] = {c01.y, c01.w, c23.y, c23.w};
#pragma unroll
                        for (int i = 0; i < 4; ++i) v[i] = second ? (pr[i] * snv[i] + v[i] * csv[i]) : (v[i] * csv[i] - pr[i] * snv[i]);
                      }
                      if (n < 576) {
                        uint2 o;
                        o.x = pack2(v[0] * MLA_QS, v[1] * MLA_QS);
                        o.y = pack2(v[2] * MLA_QS, v[3] * MLA_QS);
                        *(uint2*)(QM + (size_t)tok * 576 + n) = o;
                      }
                    }
                  }
                });
      continue;
    }
    id -= N_G2;
    if (id < N_G3) {
      const int mt = id / 6, nt = id % 6;
      __syncthreads();
      tile_rowscale(PJ + C_MKVA, INW, mt * 128, 256, rs);
      gemm_tile((unsigned*)(p.ws + OFF_Y) + 8, PJ + C_MKVA, INW, nullptr, mt * 128, 128, WKVB + (size_t)nt * 128 * 256, 256, 256, (bf16_t*)smem,
                [&](f32x4 (&acc)[4][4], int wm, int wn, int lane) {
#pragma unroll
                  for (int ni = 0; ni < 4; ++ni) {
                    const int cl = ni * 16 + (lane >> 4) * 4;
#pragma unroll
                    for (int mi = 0; mi < 4; ++mi) {
                      const int ml = wm * 64 + mi * 16 + (lane & 15);
                      const int tok = mt * 128 + ml;
                      const float rsc = rs[ml];
                      float v[4];
#pragma unroll
                      for (int i = 0; i < 4; ++i) v[i] = acc[ni][mi][i] * rsc;
                      if (wn == 0) {
                        uint2 o;
                        o.x = pack2(v[0], v[1]);
                        o.y = pack2(v[2], v[3]);
                        *(uint2*)(KVM + (size_t)tok * 768 + nt * 128 + cl) = o;
                      } else {
                        int b, pp;
                        tok_bp(tok, b, pp);
                        bf16_t* vt = VTM + ((size_t)((b * 6 + nt) * 64 + cl)) * LK + pp;
#pragma unroll
                        for (int i = 0; i < 4; ++i) vt[(size_t)i * LK] = f2bf(v[i]);
                      }
                    }
                  }
                });
      continue;
    }
    id -= N_G3;
    if (id < N_PREP) { prep_item(p, l, id, smem); continue; }
    id -= N_PREP;
    gla_u_item(p, l, id, smem);
  }
}

template <bool MLA>
DI void attn_item(const bf16_t* __restrict__ Qb, int ldq, const bf16_t* __restrict__ Kb, int ldk, const bf16_t* __restrict__ KRb,
                  const bf16_t* __restrict__ Vt, int b, int qtok0, int ntiles, bool ctxq, bf16_t* __restrict__ outp, bf16_t* smem) {
  constexpr int DQK = MLA ? 96 : 64;
  constexpr int KST = DQK + 8;
  constexpr int CPR = DQK / 8;
  constexpr int NKC = 64 * CPR / 256;
  constexpr int NKS = DQK / 32;
  constexpr int BUF = 64 * KST + 64 * 72;
  const int tid = otid(), lane = tid & 63, wave = tid >> 6;
  const int l15 = lane & 15, lg = lane >> 4;
  bf16x8 qf[2][NKS];
#pragma unroll
  for (int mi = 0; mi < 2; ++mi)
#pragma unroll
    for (int ks = 0; ks < NKS; ++ks)
      qf[mi][ks] = *(const bf16x8*)(Qb + (size_t)(qtok0 + wave * 32 + mi * 16 + l15) * ldq + ks * 32 + lg * 8);
  int krow[NKC], kcc[NKC];
#pragma unroll
  for (int j = 0; j < NKC; ++j) { int c = tid + 256 * j; krow[j] = c / CPR; kcc[j] = c % CPR; }
  u32x4 rk[NKC], rv[2];
  auto load_tile = [&](int kt) {
    int ktok0;
    if (ctxq || kt < 4) ktok0 = NL + b * 256 + kt * 64; else ktok0 = b * 8192 + (kt - 4) * 64;
#pragma unroll
    for (int j = 0; j < NKC; ++j) {
      const bf16_t* src;
      if (MLA && kcc[j] >= 8) src = KRb + (size_t)(ktok0 + krow[j]) * 32 + (kcc[j] - 8) * 8;
      else src = Kb + (size_t)(ktok0 + krow[j]) * ldk + kcc[j] * 8;
      rk[j] = *(const u32x4*)src;
    }
#pragma unroll
    for (int j = 0; j < 2; ++j) {
      int c = tid + 256 * j;
      rv[j] = *(const u32x4*)(Vt + (size_t)(c >> 3) * LK + kt * 64 + (c & 7) * 8);
    }
  };
  auto store_tile = [&](int buf) {
    bf16_t* Ks = smem + buf * BUF;
    bf16_t* Vs = Ks + 64 * KST;
#pragma unroll
    for (int j = 0; j < NKC; ++j) *(u32x4*)(Ks + krow[j] * KST + kcc[j] * 8) = rk[j];
#pragma unroll
    for (int j = 0; j < 2; ++j) { int c = tid + 256 * j; *(u32x4*)(Vs + (c >> 3) * 72 + (c & 7) * 8) = rv[j]; }
  };
  f32x4 o[4][2];
#pragma unroll
  for (int a = 0; a < 4; ++a)
#pragma unroll
    for (int c = 0; c < 2; ++c) o[a][c] = f32x4{0.f, 0.f, 0.f, 0.f};
  float mrun[2] = {-1e30f, -1e30f}, lrun[2] = {0.f, 0.f};
  __syncthreads();
  load_tile(0);
  store_tile(0);
  if (ntiles > 1) load_tile(1);
  __syncthreads();
  for (int kt = 0; kt < ntiles; ++kt) {
    if (kt + 1 < ntiles) {
      store_tile((kt + 1) & 1);
      if (kt + 2 < ntiles) load_tile(kt + 2);
    }
    const bf16_t* Ks = smem + (kt & 1) * BUF;
    const bf16_t* Vs = Ks + 64 * KST;
    f32x4 s[2][4];
#pragma unroll
    for (int mi = 0; mi < 2; ++mi)
#pragma unroll
      for (int ni = 0; ni < 4; ++ni) s[mi][ni] = f32x4{0.f, 0.f, 0.f, 0.f};
#pragma unroll
    for (int ks = 0; ks < NKS; ++ks) {
#pragma unroll
      for (int ni = 0; ni < 4; ++ni) {
        bf16x8 kf = *(const bf16x8*)(Ks + (ni * 16 + l15) * KST + ks * 32 + lg * 8);
#pragma unroll
        for (int mi = 0; mi < 2; ++mi) s[mi][ni] = MFMA16(kf, qf[mi][ks], s[mi][ni]);
      }
    }
    float pmx[2];
    bool need = false;
#pragma unroll
    for (int mi = 0; mi < 2; ++mi) {
      float mx = fmaxf(fmaxf(s[mi][0][0], s[mi][0][1]), fmaxf(s[mi][0][2], s[mi][0][3]));
#pragma unroll
      for (int ni = 1; ni < 4; ++ni) mx = fmaxf(mx, fmaxf(fmaxf(s[mi][ni][0], s[mi][ni][1]), fmaxf(s[mi][ni][2], s[mi][ni][3])));
      pmx[mi] = mx;
      need = need || (mx > mrun[mi] + 8.f);
    }
    if (__any(need)) {
#pragma unroll
      for (int mi = 0; mi < 2; ++mi) {
        float mx = pmx[mi];
        mx = fmaxf(mx, __shfl_xor(mx, 16));
        mx = fmaxf(mx, __shfl_xor(mx, 32));
        const float mnew = fmaxf(mrun[mi], mx);
        const float alpha = __builtin_amdgcn_exp2f(mrun[mi] - mnew);
        mrun[mi] = mnew;
        lrun[mi] *= alpha;
#pragma unroll
        for (int nd = 0; nd < 4; ++nd)
#pragma unroll
          for (int i = 0; i < 4; ++i) o[nd][mi][i] *= alpha;
      }
    }
    bf16x8 pf[2][2];
#pragma unroll
    for (int mi = 0; mi < 2; ++mi) {
      const float mref = mrun[mi];
      f32x2 rs2 = {0.f, 0.f};
#pragma unroll
      for (int ni = 0; ni < 4; ++ni) {
        f32x2 p01 = {__builtin_amdgcn_exp2f(s[mi][ni][0] - mref), __builtin_amdgcn_exp2f(s[mi][ni][1] - mref)};
        f32x2 p23 = {__builtin_amdgcn_exp2f(s[mi][ni][2] - mref), __builtin_amdgcn_exp2f(s[mi][ni][3] - mref)};
        rs2 += p01;
        rs2 += p23;
        s[mi][ni][0] = p01[0]; s[mi][ni][1] = p01[1]; s[mi][ni][2] = p23[0]; s[mi][ni][3] = p23[1];
      }
      lrun[mi] += rs2[0] + rs2[1];
#pragma unroll
      for (int s2 = 0; s2 < 2; ++s2) {
        u32x4 u = {pack2(s[mi][2 * s2][0], s[mi][2 * s2][1]), pack2(s[mi][2 * s2][2], s[mi][2 * s2][3]),
                   pack2(s[mi][2 * s2 + 1][0], s[mi][2 * s2 + 1][1]), pack2(s[mi][2 * s2 + 1][2], s[mi][2 * s2 + 1][3])};
        pf[mi][s2] = __builtin_bit_cast(bf16x8, u);
      }
    }
#pragma unroll
    for (int s2 = 0; s2 < 2; ++s2) {
#pragma unroll
      for (int nd = 0; nd < 4; ++nd) {
        const bf16_t* vb = Vs + (nd * 16 + l15) * 72 + 32 * s2 + 4 * lg;
        uint2 lo = *(const uint2*)vb, hi = *(const uint2*)(vb + 16);
        u32x4 u = {lo.x, lo.y, hi.x, hi.y};
        bf16x8 vf = __builtin_bit_cast(bf16x8, u);
#pragma unroll
        for (int mi = 0; mi < 2; ++mi) o[nd][mi] = MFMA16(vf, pf[mi][s2], o[nd][mi]);
      }
    }
    __syncthreads();
  }
#pragma unroll
  for (int mi = 0; mi < 2; ++mi) {
    float lt = lrun[mi];
    lt += __shfl_xor(lt, 16);
    lt += __shfl_xor(lt, 32);
    const float inv = 1.f / lt;
    const int q = qtok0 + wave * 32 + mi * 16 + l15;
#pragma unroll
    for (int nd = 0; nd < 4; ++nd) {
      uint2 w;
      w.x = pack2(o[nd][mi][0] * inv, o[nd][mi][1] * inv);
      w.y = pack2(o[nd][mi][2] * inv, o[nd][mi][3] * inv);
      *(uint2*)(outp + (size_t)q * 1024 + nd * 16 + lg * 4) = w;
    }
  }
}

DI void attn_dispatch(const Params& p, int combo, int qt, bool ctxq, char* smem) {
  const bf16_t* QM = (const bf16_t*)(p.ws + OFF_QM);
  const bf16_t* KVM = (const bf16_t*)(p.ws + OFF_KVM);
  const bf16_t* KR = (const bf16_t*)(p.ws + OFF_KR);
  const bf16_t* QG = (const bf16_t*)(p.ws + OFF_QG);
  const bf16_t* KG = (const bf16_t*)(p.ws + OFF_KG);
  const bf16_t* VTM = (const bf16_t*)(p.ws + OFF_VTM);
  const bf16_t* VTG = (const bf16_t*)(p.ws + OFF_VTG);
  bf16_t* CAT = (bf16_t*)(p.ws + OFF_CAT);
  const bool mla = combo < 12;
  const int c2 = mla ? combo : combo - 12;
  const int b = c2 / 6, h = c2 % 6;
  const int qtok0 = ctxq ? NL + b * 256 + qt * 128 : b * 8192 + qt * 128;
  const int ntiles = ctxq ? 4 : 132;
  if (mla)
    attn_item<true>(QM + h * 96, 576, KVM + h * 128, 768, KR, VTM + (size_t)((b * 6 + h) * 64) * LK, b, qtok0, ntiles, ctxq,
                    CAT + 256 + h * 64, (bf16_t*)smem);
  else {
    const int kvh = h / 3;
    attn_item<false>(QG + h * 64, 384, KG + kvh * 64, 128, nullptr, VTG + (size_t)((b * 2 + kvh) * 64) * LK, b, qtok0, ntiles, ctxq,
                     CAT + 640 + h * 64, (bf16_t*)smem);
  }
}

DI void scan_item(const Params& p, int item) {
  const float* __restrict__ U = (const float*)(p.ws + OFF_U);
  const float* __restrict__ DEC = (const float*)(p.ws + OFF_DEC);
  float* __restrict__ SP = (float*)(p.ws + OFF_SP);
  const int eb = item & 7, dir = (item >> 3) & 1, h = (item >> 4) & 3, b = item >> 6;
  const int idx = eb * 256 + otid();
  const int d = idx >> 6;
  float s = 0.f;
#pragma unroll 4
  for (int step = 0; step < 132; ++step) {
    int cidx;
    if (step < 4) cidx = 256 + b * 4 + (dir ? 3 - step : step);
    else { int n = step - 4; cidx = b * 128 + (dir ? 127 - n : n); }
    const int it = (cidx * 4 + h) * 2 + dir;
    const float u = U[(size_t)it * 2048 + idx];
    const float dc = DEC[it * 32 + d];
    SP[(size_t)it * 2048 + idx] = s;
    s = dc * s + u;
  }
}

DI void phaseD(const Params& p, int l, char* smem) {
  const int n_ctx = (l < 3) ? 48 : 0;
  const int bid = obid(), G = gridDim.x;
  for (int it = bid; it < 128; it += G) scan_item(p, it);
  if (G == 512) {
    for (int r = 0; r < 3; ++r) attn_dispatch(p, r * 8 + (bid & 7), bid >> 3, false, smem);
  } else {
    for (int it = bid; it < 1536; it += G) attn_dispatch(p, it >> 6, it & 63, false, smem);
  }
  for (int it = (bid + 200) % G; it < n_ctx; it += G) attn_dispatch(p, it >> 1, it & 1, true, smem);
}

DI void gla_out_item(const Params& p, int l, int item, char* smem) {
  const bf16_t* PJ = (const bf16_t*)(p.ws + OFF_PJ);
  const float* SP = (const float*)(p.ws + OFF_SP);
  bf16_t* CAT = (bf16_t*)(p.ws + OFF_CAT);
  const int h = item & 3, cidx = item >> 2;
  const int tok0 = chunk_tok0(cidx);
  float* la = (float*)smem;
  float* blast = la + 2048;
  float* segtot = blast + 32;
  bf16_t* VT = (bf16_t*)(segtot + 256 + 544);
  bf16_t* QD = VT + 64 * 72;
  bf16_t* KI = QD + 64 * 40;
  bf16_t* ST = KI + 64 * 40;
  const int tid = otid(), lane = tid & 63, wave = tid >> 6;
  const int l15 = lane & 15, lg = lane >> 4;
  const int t = tid >> 2;
  __syncthreads();
  {
    const int e0 = (tid & 3) * 16;
    const bf16_t* vp = PJ + (size_t)(tok0 + t) * INW + C_GV + h * 64 + e0;
    const u32x4 v0 = *(const u32x4*)vp, v1 = *(const u32x4*)(vp + 8);
#pragma unroll
    for (int q = 0; q < 8; ++q) {
      const unsigned w0 = v0[q >> 1], w1 = v1[q >> 1];
      VT[(e0 + q) * 72 + t] = (bf16_t)((q & 1) ? (w0 >> 16) : (w0 & 0xffffu));
      VT[(e0 + 8 + q) * 72 + t] = (bf16_t)((q & 1) ? (w1 >> 16) : (w1 & 0xffffu));
    }
  }
  f32x4 o[4];
#pragma unroll
  for (int et = 0; et < 4; ++et) o[et] = f32x4{0.f, 0.f, 0.f, 0.f};
#pragma unroll 1
  for (int dir = 0; dir < 2; ++dir) {
    const float* W = (dir ? p.w_gb : p.w_gf) + l * 16 * 128;
    const float* bias = (dir ? p.b_gb : p.b_gf) + l * 128;
    __syncthreads();
    gla_cumsum(PJ, tok0, dir, W, bias, h, la, blast, segtot);
    {
      const int d0 = (tid & 3) * 8;
      const u32x4 qr = *(const u32x4*)(PJ + (size_t)(tok0 + t) * INW + C_GQ + h * 32 + d0);
      const u32x4 kr = *(const u32x4*)(PJ + (size_t)(tok0 + t) * INW + C_GK + h * 32 + d0);
      u32x4 qo, ko;
#pragma unroll
      for (int q2 = 0; q2 < 4; ++q2) {
        const float b0 = la[t * 32 + d0 + 2 * q2], b1 = la[t * 32 + d0 + 2 * q2 + 1];
        const float q0 = __uint_as_float(qr[q2] << 16), q1 = __uint_as_float(qr[q2] & 0xffff0000u);
        const float k0 = __uint_as_float(kr[q2] << 16), k1 = __uint_as_float(kr[q2] & 0xffff0000u);
        qo[q2] = pack2(q0 * GLA_QS * __expf(b0), q1 * GLA_QS * __expf(b1));
        ko[q2] = pack2(k0 * __expf(-b0), k1 * __expf(-b1));
      }
      *(u32x4*)(QD + t * 40 + d0) = qo;
      *(u32x4*)(KI + t * 40 + d0) = ko;
      const int it = (cidx * 4 + h) * 2 + dir;
      const int sd = tid >> 3, se0 = (tid & 7) * 8;
      const float* sp = SP + (size_t)it * 2048 + sd * 64 + se0;
      const float4 s0 = *(const float4*)sp, s1 = *(const float4*)(sp + 4);
      const float sv[8] = {s0.x, s0.y, s0.z, s0.w, s1.x, s1.y, s1.z, s1.w};
#pragma unroll
      for (int q = 0; q < 8; ++q) ST[(se0 + q) * 40 + sd] = f2bf(sv[q]);
    }
    __syncthreads();
    const bf16x8 qf = *(const bf16x8*)(QD + (wave * 16 + l15) * 40 + lg * 8);
    f32x4 at[4];
#pragma unroll
    for (int jt = 0; jt < 4; ++jt) {
      const bf16x8 kf = *(const bf16x8*)(KI + (jt * 16 + l15) * 40 + lg * 8);
      at[jt] = MFMA16(kf, qf, (f32x4{0.f, 0.f, 0.f, 0.f}));
      const int i = wave * 16 + l15;
#pragma unroll
      for (int r = 0; r < 4; ++r) {
        const int j = jt * 16 + lg * 4 + r;
        const bool keep = dir ? (j >= i) : (j <= i);
        at[jt][r] = keep ? at[jt][r] : 0.f;
      }
    }
#pragma unroll
    for (int s2 = 0; s2 < 2; ++s2) {
      u32x4 u = {pack2(at[2 * s2][0], at[2 * s2][1]), pack2(at[2 * s2][2], at[2 * s2][3]),
                 pack2(at[2 * s2 + 1][0], at[2 * s2 + 1][1]), pack2(at[2 * s2 + 1][2], at[2 * s2 + 1][3])};
      const bf16x8 pf = __builtin_bit_cast(bf16x8, u);
#pragma unroll
      for (int et = 0; et < 4; ++et) {
        const bf16_t* vb = VT + (et * 16 + l15) * 72 + 32 * s2 + 4 * lg;
        const uint2 lo = *(const uint2*)vb, hi = *(const uint2*)(vb + 16);
        u32x4 vu = {lo.x, lo.y, hi.x, hi.y};
        o[et] = MFMA16(__builtin_bit_cast(bf16x8, vu), pf, o[et]);
      }
    }
#pragma unroll
    for (int et = 0; et < 4; ++et) {
      const bf16x8 sf = *(const bf16x8*)(ST + (et * 16 + l15) * 40 + lg * 8);
      o[et] = MFMA16(sf, qf, o[et]);
    }
  }
  float ss = 0.f;
#pragma unroll
  for (int et = 0; et < 4; ++et)
#pragma unroll
    for (int r = 0; r < 4; ++r) ss += o[et][r] * o[et][r];
  ss += __shfl_xor(ss, 16);
  ss += __shfl_xor(ss, 32);
  const float rn = rsqrtf(ss * (1.f / 64.f) + 1e-6f);
  const int tok = tok0 + wave * 16 + l15;
#pragma unroll
  for (int et = 0; et < 4; ++et) {
    const int e = et * 16 + lg * 4;
    const uint2 rr = *(const uint2*)(PJ + (size_t)tok * INW + C_GR + h * 64 + e);
    const float4 gg = *(const float4*)(p.g_gla + l * 64 + e);
    const float r0 = __uint_as_float(rr.x << 16), r1 = __uint_as_float(rr.x & 0xffff0000u);
    const float r2 = __uint_as_float(rr.y << 16), r3 = __uint_as_float(rr.y & 0xffff0000u);
    uint2 w;
    w.x = pack2(o[et][0] * rn * gg.x * siluf(r0), o[et][1] * rn * gg.y * siluf(r1));
    w.y = pack2(o[et][2] * rn * gg.z * siluf(r2), o[et][3] * rn * gg.w * siluf(r3));
    *(uint2*)(CAT + (size_t)tok * 1024 + h * 64 + e) = w;
  }
}

DI void phaseE(const Params& p, int l, char* smem) {
  const int n = (l < 3 ? 264 : 256) * 4;
  for (int it = obid(); it < n; it += gridDim.x) gla_out_item(p, l, it, smem);
}

DI void phaseF(const Params& p, int l, char* smem) {
  const bf16_t* CAT = (const bf16_t*)(p.ws + OFF_CAT);
  const bf16_t* WOUT = (const bf16_t*)(p.ws + OFF_WOUT) + (size_t)l * 1048576;
  const float* XF = (const float*)(p.ws + OFF_XF);
  const float* MOD = (const float*)(p.ws + OFF_MOD) + (size_t)l * 3 * 6144;
  float* Y = (float*)(p.ws + OFF_Y);
  const int nmt = (l < 3 ? 132 : 128);
  const int ntiles = nmt * 8;
  const int bid_ = obid();
  const bool xmap = (gridDim.x == 512);
  const int xn = xmap ? ((nmt - (bid_ & 7) + 7) >> 3) * 8 : 0;
  for (int t_ = xmap ? (bid_ >> 3) : bid_; t_ < (xmap ? xn : ntiles); t_ += (xmap ? 64 : (int)gridDim.x)) {
    const int mt = xmap ? (bid_ & 7) + 8 * (t_ >> 3) : (t_ >> 3), nt = t_ & 7;
    gemm_tile((unsigned*)(p.ws + OFF_Y) + 8, CAT, 1024, nullptr, mt * 128, 128, WOUT + (size_t)nt * 128 * 1024, 1024, 1024, (bf16_t*)smem,
              [&](f32x4 (&acc)[4][4], int wm, int wn, int lane) {
                const float* g1 = MOD + (size_t)tok_set(mt * 128) * 6144 + 2048;
#pragma unroll
                for (int ni = 0; ni < 4; ++ni) {
                  const int n = nt * 128 + wn * 64 + ni * 16 + (lane >> 4) * 4;
                  const float4 g = *(const float4*)(g1 + n);
#pragma unroll
                  for (int mi = 0; mi < 4; ++mi) {
                    const int m = mt * 128 + wm * 64 + mi * 16 + (lane & 15);
                    const float4 xv = *(const float4*)(XF + (size_t)m * 1024 + n);
                    float4 r;
                    r.x = ALPHA * xv.x + g.x * acc[ni][mi][0];
                    r.y = ALPHA * xv.y + g.y * acc[ni][mi][1];
                    r.z = ALPHA * xv.z + g.z * acc[ni][mi][2];
                    r.w = ALPHA * xv.w + g.w * acc[ni][mi][3];
                    *(float4*)(Y + (size_t)m * 1024 + n) = r;
                  }
                }
              });
  }
}

DI void phaseG(const Params& p, int l) {
  const int ntok = (l < 3) ? NT : NL;
  const int tid_ = otid(); const int lane = tid_ & 63, wave = tid_ >> 6;
  const float* Y = (const float*)(p.ws + OFF_Y);
  float* XF = (float*)(p.ws + OFF_XF);
  bf16_t* HB = (bf16_t*)(p.ws + OFF_HB);
  float* AFFT = (float*)(p.ws + OFF_AFFT);
  const float* MODl = (const float*)(p.ws + OFF_MOD) + (size_t)l * 3 * 6144;
  const float* g = p.ln1_g + l * 1024;
  const float* bb = p.ln1_b + l * 1024;
  const float* wr = p.w_router + (size_t)l * 1024 * 16;
  const int ngroups = ntok >> 1;
  for (int tg = obid() * 4 + wave; tg < ngroups; tg += gridDim.x * 4) {
    const int tok0 = tg * 2;
    const float* md = MODl + (size_t)tok_set(tok0) * 6144;
    float v[2][16];
#pragma unroll
    for (int t = 0; t < 2; ++t)
#pragma unroll
      for (int j = 0; j < 4; ++j) {
        float4 t4 = *(const float4*)(Y + (size_t)(tok0 + t) * 1024 + j * 256 + lane * 4);
        v[t][4 * j] = t4.x; v[t][4 * j + 1] = t4.y; v[t][4 * j + 2] = t4.z; v[t][4 * j + 3] = t4.w;
      }
    float mean[2], rstd[2];
#pragma unroll
    for (int t = 0; t < 2; ++t) {
      float s = 0.f;
#pragma unroll
      for (int q = 0; q < 16; ++q) s += v[t][q];
      mean[t] = wave_sum(s) * (1.f / 1024.f);
      float qq = 0.f;
#pragma unroll
      for (int q = 0; q < 16; ++q) { float dlt = v[t][q] - mean[t]; qq += dlt * dlt; }
      rstd[t] = rsqrtf(wave_sum(qq) * (1.f / 1024.f) + 1e-6f);
    }
    float lg[32];
#pragma unroll
    for (int q = 0; q < 32; ++q) lg[q] = 0.f;
#pragma unroll
    for (int j = 0; j < 4; ++j) {
      const int col = j * 256 + lane * 4;
      const float4 g4 = *(const float4*)(g + col), b4 = *(const float4*)(bb + col);
      const float4 sh = *(const float4*)(md + 3072 + col), sc = *(const float4*)(md + 4096 + col);
      const float gg[4] = {g4.x, g4.y, g4.z, g4.w}, bv[4] = {b4.x, b4.y, b4.z, b4.w};
      const float shv[4] = {sh.x, sh.y, sh.z, sh.w}, scv[4] = {sc.x, sc.y, sc.z, sc.w};
      float hh[2][4];
#pragma unroll
      for (int t = 0; t < 2; ++t) {
        float xn[4];
#pragma unroll
        for (int c = 0; c < 4; ++c) {
          xn[c] = (v[t][4 * j + c] - mean[t]) * rstd[t] * gg[c] + bv[c];
          hh[t][c] = xn[c] * (1.f + scv[c]) + shv[c];
        }
        *(float4*)(XF + (size_t)(tok0 + t) * 1024 + col) = make_float4(xn[0], xn[1], xn[2], xn[3]);
        uint2 o;
        o.x = pack2(hh[t][0], hh[t][1]);
        o.y = pack2(hh[t][2], hh[t][3]);
        *(uint2*)(HB + (size_t)(tok0 + t) * 1024 + col) = o;
      }
#pragma unroll
      for (int c = 0; c < 4; ++c) {
        const float4* wrow = (const float4*)(wr + (size_t)(col + c) * 16);
        const float4 w0 = wrow[0], w1 = wrow[1], w2 = wrow[2], w3 = wrow[3];
        const float wv[16] = {w0.x, w0.y, w0.z, w0.w, w1.x, w1.y, w1.z, w1.w, w2.x, w2.y, w2.z, w2.w, w3.x, w3.y, w3.z, w3.w};
#pragma unroll
        for (int t = 0; t < 2; ++t)
#pragma unroll
          for (int e = 0; e < 16; ++e) lg[t * 16 + e] += hh[t][c] * wv[e];
      }
    }
#define BFLY_STEP(OFF, N) { const bool up = (lane & (OFF)) != 0; _Pragma("unroll") for (int i = 0; i < (N); ++i) { const float a = lg[i], b = lg[i + (N)]; const float send = up ? a : b, keep = up ? b : a; lg[i] = keep + __shfl_xor(send, (OFF)); } }
    BFLY_STEP(32, 16) BFLY_STEP(16, 8) BFLY_STEP(8, 4) BFLY_STEP(4, 2) BFLY_STEP(2, 1)
#undef BFLY_STEP
    const float logit = lg[0] + __shfl_xor(lg[0], 1);
    float mx = logit;
#pragma unroll
    for (int o = 16; o >= 2; o >>= 1) mx = fmaxf(mx, __shfl_xor(mx, o));
    const float ex = expf(logit - mx);
    float den = ex;
#pragma unroll
    for (int o = 16; o >= 2; o >>= 1) den += __shfl_xor(den, o);
    if ((lane & 1) == 0) AFFT[(size_t)tok0 * 16 + (lane >> 1)] = ex / den;
  }
}

DI void topk_job(const float* __restrict__ aff, int n, int cap, int rowbase, int tokbase, int* __restrict__ SELe, int* __restrict__ ROWTOK,
                 float* __restrict__ GATEV, unsigned* sm) {
  const int tid = otid();
  unsigned* hist = sm;
  unsigned* ctl = sm + 256;
  unsigned v[32];
#pragma unroll
  for (int j = 0; j < 32; ++j) { int idx = j * 256 + tid; v[j] = idx < n ? __float_as_uint(aff[(size_t)idx * 16]) : 0u; }
  __syncthreads();
  if (tid == 0) { ctl[0] = 0u; ctl[1] = (unsigned)cap; ctl[2] = 0u; }
  __syncthreads();
  unsigned prefix = 0u, remaining = (unsigned)cap;
#pragma unroll 1
  for (int pass = 0; pass < 4; ++pass) {
    const int shift = 24 - 8 * pass;
    const unsigned hm = pass == 0 ? 0u : (0xFFFFFFFFu << (shift + 8));
    hist[tid] = 0u;
    __syncthreads();
#pragma unroll
    for (int j = 0; j < 32; ++j) {
      int idx = j * 256 + tid;
      if (idx < n && (v[j] & hm) == prefix) atomicAdd(&hist[(v[j] >> shift) & 255u], 1u);
    }
    __syncthreads();
    if (tid < 64) {
      const int L = tid;
      const unsigned h0 = hist[255 - 4 * L], h1 = hist[254 - 4 * L], h2 = hist[253 - 4 * L], h3 = hist[252 - 4 * L];
      const unsigned tot = h0 + h1 + h2 + h3;
      unsigned inc = tot;
#pragma unroll
      for (int o = 1; o < 64; o <<= 1) { const unsigned t = __shfl_up(inc, o); if (L >= o) inc += t; }
      const unsigned exc = inc - tot;
      const bool last = (L == 63);
      if ((exc < remaining && inc >= remaining) || (last && inc < remaining)) {
        unsigned c = exc;
        int bin = 255 - 4 * L;
        if (c + h0 < remaining) { c += h0; bin = 254 - 4 * L;
          if (c + h1 < remaining) { c += h1; bin = 253 - 4 * L;
            if (c + h2 < remaining) { c += h2; bin = 252 - 4 * L; } } }
        ctl[0] = prefix | ((unsigned)bin << shift);
        ctl[1] = remaining - c;
      }
    }
    __syncthreads();
    prefix = ctl[0];
    remaining = ctl[1];
    if (pass < 3) __syncthreads();
  }
  const unsigned T = prefix;
  const int lane = tid & 63, wave = tid >> 6;
  unsigned* wcG = sm + 264;
  unsigned* wcE = wcG + 128;
  unsigned* baseG = wcE + 128;
  unsigned* baseE = baseG + 128;
#pragma unroll
  for (int j = 0; j < 32; ++j) {
    const int idx = j * 256 + tid;
    const bool valid = idx < n;
    const unsigned long long bg = __ballot(valid && v[j] > T), be = __ballot(valid && v[j] == T);
    if (lane == 0) { wcG[j * 4 + wave] = (unsigned)__popcll(bg); wcE[j * 4 + wave] = (unsigned)__popcll(be); }
  }
  __syncthreads();
  {
    const unsigned* src = tid < 128 ? wcG : wcE;
    unsigned* dst = tid < 128 ? baseG : baseE;
    const int t2 = tid & 127;
    unsigned a = 0u;
    for (int i = 0; i < t2; ++i) a += src[i];
    dst[t2] = a;
  }
  __syncthreads();
  const unsigned cntGT = baseG[127] + wcG[127];
  const unsigned long long ltmask = (1ull << lane) - 1ull;
#pragma unroll
  for (int j = 0; j < 32; ++j) {
    const int idx = j * 256 + tid;
    const bool valid = idx < n;
    const bool g = valid && v[j] > T, q = valid && v[j] == T;
    const unsigned long long bg = __ballot(g), be = __ballot(q);
    int row = -1;
    if (g) row = rowbase + (int)(baseG[j * 4 + wave] + (unsigned)__popcll(bg & ltmask));
    else if (q) {
      const unsigned r = baseE[j * 4 + wave] + (unsigned)__popcll(be & ltmask);
      if (r < remaining) row = rowbase + (int)(cntGT + r);
    }
    if (valid) {
      SELe[tokbase + idx] = row;
      if (row >= 0) { ROWTOK[row] = tokbase + idx; GATEV[row] = __uint_as_float(v[j]); }
    }
  }
  __syncthreads();
}

DI void phaseH(const Params& p, int l, char* smem) {
  const float* AFFT = (const float*)(p.ws + OFF_AFFT);
  int* SEL = (int*)(p.ws + OFF_SEL);
  int* ROWTOK = (int*)(p.ws + OFF_ROWTOK);
  float* GATEV = (float*)(p.ws + OFF_GATEV);
  const int njobs = (l < 3) ? 64 : 32;
  for (int job = obid(); job < njobs; job += gridDim.x) {
    if (job < 32) {
      const int e = job >> 1, b = job & 1;
      topk_job(AFFT + (size_t)(b * 8192) * 16 + e, 8192, 1024, (e * 2 + b) * 1024, b * 8192, SEL + (size_t)e * NT, ROWTOK, GATEV, (unsigned*)smem);
    } else {
      const int j2 = job - 32;
      const int e = j2 >> 1, b = j2 & 1;
      topk_job(AFFT + (size_t)(NL + b * 256) * 16 + e, 256, 32, 32768 + (e * 2 + b) * 32, NL + b * 256, SEL + (size_t)e * NT, ROWTOK, GATEV,
               (unsigned*)smem);
    }
  }
}

DI void phaseI(const Params& p, int l, char* smem) {
  const bf16_t* HB = (const bf16_t*)(p.ws + OFF_HB);
  const bf16_t* WGU = (const bf16_t*)(p.ws + OFF_WGU) + (size_t)l * 16 * 2097152;
  const int* ROWTOK = (const int*)(p.ws + OFF_ROWTOK);
  const float* GATEV = (const float*)(p.ws + OFF_GATEV);
  bf16_t* HID = (bf16_t*)(p.ws + OFF_HID);
  const int nmt = (l < 3) ? 272 : 256;
  const int ntiles = nmt * 16;
  const int bid_ = obid();
  const bool xmap = (gridDim.x == 512);
  const int nloop = xmap ? ((l < 3 && (bid_ >> 3) < 32) ? 9 : 8) : (ntiles - bid_ + (int)gridDim.x - 1) / (int)gridDim.x;
  for (int r_ = 0; r_ < nloop; ++r_) {
    int mt, nt;
    if (xmap) {
      const int x = bid_ & 7, q = bid_ >> 3;
      if (r_ < 8) { const int e2 = x + 8 * (r_ >> 2); const int sub = (r_ & 3) * 64 + q; mt = e2 * 16 + (sub >> 4); nt = sub & 15; }
      else { mt = 256 + x + 8 * (q >> 4); nt = q & 15; }
    } else { const int id = bid_ + r_ * (int)gridDim.x; mt = id >> 4; nt = id & 15; }
    int e, row0, nvalid;
    if (mt < 256) { e = mt >> 4; row0 = mt * 128; nvalid = 128; }
    else { e = mt - 256; row0 = 32768 + e * 64; nvalid = 64; }
    gemm_tile((unsigned*)(p.ws + OFF_Y) + 8, HB, 1024, ROWTOK, row0, nvalid, WGU + (size_t)e * 2097152 + (size_t)nt * 128 * 1024, 1024, 1024, (bf16_t*)smem,
              [&](f32x4 (&acc)[4][4], int wm, int wn, int lane) {
#pragma unroll
                for (int ni = 0; ni < 2; ++ni) {
                  const int f = nt * 64 + wn * 32 + ni * 16 + (lane >> 4) * 4;
#pragma unroll
                  for (int mi = 0; mi < 4; ++mi) {
                    const int ml = wm * 64 + mi * 16 + (lane & 15);
                    if (ml < nvalid) {
                      const float gt = GATEV[row0 + ml];
                      float hv[4];
#pragma unroll
                      for (int i = 0; i < 4; ++i) hv[i] = siluf(acc[ni][mi][i]) * acc[ni + 2][mi][i] * gt;
                      uint2 o;
                      o.x = pack2(hv[0], hv[1]);
                      o.y = pack2(hv[2], hv[3]);
                      *(uint2*)(HID + (size_t)(row0 + ml) * 1024 + f) = o;
                    }
                  }
                }
              });
  }
}

DI void phaseJ(const Params& p, int l, char* smem) {
  const bf16_t* HID = (const bf16_t*)(p.ws + OFF_HID);
  const bf16_t* WD = (const bf16_t*)(p.ws + OFF_WD) + (size_t)l * 16 * 1048576;
  const float* GATEV = (const float*)(p.ws + OFF_GATEV);
  bf16_t* EOUT = (bf16_t*)(p.ws + OFF_EOUT);
  const int nmt = (l < 3) ? 272 : 256;
  const int ntiles = nmt * 8;
  const int bid_ = obid();
  const bool xmap = (gridDim.x == 512);
  const int nloop = xmap ? ((l < 3 && (bid_ >> 3) < 16) ? 5 : 4) : (ntiles - bid_ + (int)gridDim.x - 1) / (int)gridDim.x;
  for (int r_ = 0; r_ < nloop; ++r_) {
    int mt, nt;
    if (xmap) {
      const int x = bid_ & 7, q = bid_ >> 3;
      if (r_ < 4) { const int e2 = x + 8 * (r_ >> 1); const int sub = (r_ & 1) * 64 + q; mt = e2 * 16 + (sub >> 3); nt = sub & 7; }
      else { mt = 256 + x + 8 * (q >> 3); nt = q & 7; }
    } else { const int id = bid_ + r_ * (int)gridDim.x; mt = id >> 3; nt = id & 7; }
    int e, row0, nvalid;
    if (mt < 256) { e = mt >> 4; row0 = mt * 128; nvalid = 128; }
    else { e = mt - 256; row0 = 32768 + e * 64; nvalid = 64; }
    gemm_tile((unsigned*)(p.ws + OFF_Y) + 8, HID, 1024, nullptr, row0, nvalid, WD + (size_t)e * 1048576 + (size_t)nt * 128 * 1024, 1024, 1024, (bf16_t*)smem,
              [&](f32x4 (&acc)[4][4], int wm, int wn, int lane) {
#pragma unroll
                for (int mi = 0; mi < 4; ++mi) {
                  const int ml = wm * 64 + mi * 16 + (lane & 15);
                  if (ml < nvalid) {
#pragma unroll
                    for (int ni = 0; ni < 4; ++ni) {
                      const int n = nt * 128 + wn * 64 + ni * 16 + (lane >> 4) * 4;
                      uint2 o;
                      o.x = pack2(acc[ni][mi][0], acc[ni][mi][1]);
                      o.y = pack2(acc[ni][mi][2], acc[ni][mi][3]);
                      *(uint2*)(EOUT + (size_t)(row0 + ml) * 1024 + n) = o;
                    }
                  }
                }
              });
  }
}

DI void phaseK(const Params& p, int l) {
  const int ntok = (l < 3) ? NT : NL;
  const int tid_ = otid(); const int lane = tid_ & 63, wave = tid_ >> 6;
  float* XF = (float*)(p.ws + OFF_XF);
  bf16_t* HB = (bf16_t*)(p.ws + OFF_HB);
  const bf16_t* EOUT = (const bf16_t*)(p.ws + OFF_EOUT);
  const int* SEL = (const int*)(p.ws + OFF_SEL);
  const float* MODl = (const float*)(p.ws + OFF_MOD) + (size_t)l * 3 * 6144;
  const float* MODn = (const float*)(p.ws + OFF_MOD) + (size_t)(l < 3 ? l + 1 : l) * 3 * 6144;
  const float* g = p.ln2_g + l * 1024;
  const float* bb = p.ln2_b + l * 1024;
  for (int tok = obid() * 4 + wave; tok < ntok; tok += gridDim.x * 4) {
    const int set = tok_set(tok);
    const float* md = MODl + (size_t)set * 6144;
    float f[16];
#pragma unroll
    for (int q = 0; q < 16; ++q) f[q] = 0.f;
    int rowv = SEL[(size_t)(lane & 15) * NT + tok];
    {
      const int* RT = (const int*)(p.ws + OFF_ROWTOK);
      const bool okr = rowv >= 0 && rowv < NROWS_E;
      const int back = okr ? RT[rowv] : -1;
      if (back != tok) rowv = -1;
    }
#pragma unroll
    for (int e = 0; e < 16; ++e) {
      const int row = __builtin_amdgcn_readlane(rowv, e);
      if (row >= 0) {
#pragma unroll
        for (int j = 0; j < 4; ++j) {
          uint2 w = *(const uint2*)(EOUT + (size_t)row * 1024 + j * 256 + lane * 4);
          f[4 * j] += __uint_as_float(w.x << 16);
          f[4 * j + 1] += __uint_as_float(w.x & 0xffff0000u);
          f[4 * j + 2] += __uint_as_float(w.y << 16);
          f[4 * j + 3] += __uint_as_float(w.y & 0xffff0000u);
        }
      }
    }
    float v[16];
#pragma unroll
    for (int j = 0; j < 4; ++j) {
      const int col = j * 256 + lane * 4;
      float4 xv = *(const float4*)(XF + (size_t)tok * 1024 + col);
      float4 g2 = *(const float4*)(md + 5120 + col);
      v[4 * j] = ALPHA * xv.x + g2.x * f[4 * j];
      v[4 * j + 1] = ALPHA * xv.y + g2.y * f[4 * j + 1];
      v[4 * j + 2] = ALPHA * xv.z + g2.z * f[4 * j + 2];
      v[4 * j + 3] = ALPHA * xv.w + g2.w * f[4 * j + 3];
    }
    float s = 0.f;
#pragma unroll
    for (int q = 0; q < 16; ++q) s += v[q];
    const float mean = wave_sum(s) * (1.f / 1024.f);
    float qq = 0.f;
#pragma unroll
    for (int q = 0; q < 16; ++q) { float dlt = v[q] - mean; qq += dlt * dlt; }
    const float rstd = rsqrtf(wave_sum(qq) * (1.f / 1024.f) + 1e-6f);
    const float* mdn = MODn + (size_t)set * 6144;
#pragma unroll
    for (int j = 0; j < 4; ++j) {
      const int col = j * 256 + lane * 4;
      const float4 g4 = *(const float4*)(g + col), b4 = *(const float4*)(bb + col);
      float4 xn;
      xn.x = (v[4 * j] - mean) * rstd * g4.x + b4.x;
      xn.y = (v[4 * j + 1] - mean) * rstd * g4.y + b4.y;
      xn.z = (v[4 * j + 2] - mean) * rstd * g4.z + b4.z;
      xn.w = (v[4 * j + 3] - mean) * rstd * g4.w + b4.w;
      if (l < 3) {
        *(float4*)(XF + (size_t)tok * 1024 + col) = xn;
        const float4 sh = *(const float4*)(mdn + col), sc = *(const float4*)(mdn + 1024 + col);
        uint2 o;
        o.x = pack2(xn.x * (1.f + sc.x) + sh.x, xn.y * (1.f + sc.y) + sh.y);
        o.y = pack2(xn.z * (1.f + sc.z) + sh.z, xn.w * (1.f + sc.w) + sh.w);
        *(uint2*)(HB + (size_t)tok * 1024 + col) = o;
      } else {
        *(float4*)(p.out + (size_t)tok * 1024 + col) = xn;
      }
    }
  }
}


DI void probe_count(const Params& p, char* smem) {
  const int* ROWTOK = (const int*)(p.ws + OFF_ROWTOK);
  float* PV = (float*)(p.ws + OFF_Y);
  if (blockIdx.x == 0) {
    unsigned* cnt = (unsigned*)smem;
    if (threadIdx.x == 0) { cnt[0] = 0; cnt[1] = 0; }
    __syncthreads();
    for (int i = threadIdx.x; i < NROWS_E; i += 256) {
      int v = ROWTOK[i];
      if (v < 0 || v >= NT) atomicAdd(&cnt[0], 1u);
      if (i >= 32768 && (v < 0 || v >= NT)) atomicAdd(&cnt[1], 1u);
    }
    __syncthreads();
    if (threadIdx.x == 0) { PV[0] = (float)cnt[0]; PV[1] = (float)cnt[1]; }
  }
}
DI void probe_fill(const Params& p, int which) {
  const float* PV = (const float*)(p.ws + OFF_Y);
  const float v = PV[which];
  for (int i = blockIdx.x * 256 + threadIdx.x; i < NL * 1024; i += gridDim.x * 256) p.out[i] = v;
}
#define XB_TMO      128
#define XB_XCNT(j)  (256  + 64 * (j))
#define XB_XSUB(j)  (1280 + 64 * (j))
#define XB_XGEN(j)  (2304 + 64 * (j))
#define XB_TOP      3328
#define XB_TOPGEN   3392
#define XCD_BAR_WORDS 3456
#define XB_SPIN_CAP (1u << 18)
#define LAS __attribute__((address_space(3)))

__device__ __forceinline__ unsigned xb_ld(unsigned* p)              { return __hip_atomic_load(p, __ATOMIC_RELAXED, __HIP_MEMORY_SCOPE_AGENT); }
__device__ __forceinline__ unsigned xb_add(unsigned* p, unsigned v) { return __hip_atomic_fetch_add(p, v, __ATOMIC_RELAXED, __HIP_MEMORY_SCOPE_AGENT); }
__device__ __forceinline__ unsigned xb_xcc_id() { return (unsigned)__builtin_amdgcn_s_getreg((3 << 11) | 20) & 0xFu; }
#define XB_SPIN(cond, bar) do { unsigned _sp = 0; while (cond) { __builtin_amdgcn_s_sleep(1); \
    if ((++_sp & 255u) == 0u) { if (xb_ld(&(bar)[XB_TMO])) break; if (_sp > XB_SPIN_CAP) { atomicAdd(&(bar)[XB_TMO], 1u); break; } } } } while (0)

struct XcdBarrier {
    unsigned* bar; unsigned x;
    volatile LAS unsigned* st;
};

__device__ __forceinline__ XcdBarrier xcd_barrier_post(unsigned* bar, volatile LAS unsigned* st) {
    XcdBarrier b; b.bar = bar; b.x = xb_xcc_id(); b.st = st;
    if (threadIdx.x == 0) (void)xb_add(&bar[XB_XCNT(b.x)], 1u);
    return b;
}
__device__ __forceinline__ void xcd_barrier_complete(unsigned* bar, unsigned x, unsigned& nloc, unsigned& nx) {
    const unsigned G = gridDim.x * gridDim.y * gridDim.z;
    unsigned sum, cnt, mine, sp = 0u;
    for (;;) {
        sum = 0u; cnt = 0u; mine = 0u;
#pragma unroll
        for (unsigned j = 0; j < 16; ++j) { const unsigned c = xb_ld(&bar[XB_XCNT(j)]); sum += c; cnt += (c > 0u) ? 1u : 0u; mine = (j == x) ? c : mine; }
        if (sum == G) break;
        __builtin_amdgcn_s_sleep(1);
        if ((++sp & 255u) == 0u) { if (xb_ld(&bar[XB_TMO])) break; if (sp > XB_SPIN_CAP) { atomicAdd(&bar[XB_TMO], 1u); break; } }
    }
    nloc = mine > 0u ? mine : 1u; nx = cnt > 0u ? cnt : 1u;
}

__device__ __forceinline__ void xcd_barrier(const XcdBarrier& b, bool stored = true) {
    if (ALLWAVE_WB && stored) { __builtin_amdgcn_fence(__ATOMIC_RELEASE, "agent"); }
    asm volatile("s_waitcnt vmcnt(0)" ::: "memory");
    __syncthreads();
    if (threadIdx.x == 0) {
        unsigned* bar = b.bar;
        __builtin_amdgcn_s_waitcnt(0);
        unsigned nloc = b.st[0], nx = b.st[1];
        if (nloc == 0u) { xcd_barrier_complete(bar, b.x, nloc, nx); b.st[0] = nloc; b.st[1] = nx; }
        if (!ALLWAVE_WB) { __builtin_amdgcn_fence(__ATOMIC_RELEASE, "agent"); asm volatile("s_waitcnt vmcnt(0)" ::: "memory"); }
        const unsigned old = xb_add(&bar[XB_XSUB(b.x)], 1u);
        const unsigned gen = old / nloc;
        if (old + 1u == (gen + 1u) * nloc) {
            if (!ALLWAVE_WB) __builtin_amdgcn_fence(__ATOMIC_RELEASE, "agent");
            asm volatile("s_waitcnt vmcnt(0)" ::: "memory");
            const unsigned og = xb_add(&bar[XB_TOP], 1u);
            const unsigned tg = og / nx;
            if (og + 1u == (tg + 1u) * nx) xb_add(&bar[XB_TOPGEN], 1u);
            else XB_SPIN(xb_ld(&bar[XB_TOPGEN]) == tg, bar);
            __builtin_amdgcn_fence(__ATOMIC_ACQUIRE, "agent");
            xb_add(&bar[XB_XGEN(b.x)], 1u);
            asm volatile("s_waitcnt vmcnt(0)" ::: "memory");
        } else {
            XB_SPIN(xb_ld(&bar[XB_XGEN(b.x)]) == gen, bar);
            __builtin_amdgcn_fence(__ATOMIC_ACQUIRE, "agent");
            asm volatile("s_waitcnt vmcnt(0)" ::: "memory");
        }
    }
    if (BAR_DELAY && threadIdx.x == 0) { for (int q = 0; q < BAR_DELAY; ++q) __builtin_amdgcn_s_sleep(127); }
    __syncthreads();
}

#define GSYNC() xcd_barrier(xb)
#define PROBE_CHECK() { if (ph == PROBE_PH) { probe_sum(p, (const unsigned*)(p.ws + PROBE_OFF), PROBE_WORDS); GSYNC(); probe_out(p); return; } }

DI void probe_sum(const Params& p, const unsigned* buf, size_t nwords) {
  unsigned acc = 0u;
  for (size_t i = (size_t)blockIdx.x * 256 + threadIdx.x; i < nwords; i += (size_t)gridDim.x * 256) acc += buf[i] * 2654435761u + (buf[i] >> 7);
  for (int o = 32; o > 0; o >>= 1) acc += __shfl_xor(acc, o);
  if ((threadIdx.x & 63) == 0) atomicAdd((unsigned*)(p.ws + OFF_BAR) + XCD_BAR_WORDS, acc);
}
DI void probe_out(const Params& p) {
  const unsigned v = *((const unsigned*)(p.ws + OFF_BAR) + XCD_BAR_WORDS);
  const float f = (float)(v & 0xFFFFu) * (1.f / 65536.f);
  for (int i = blockIdx.x * 256 + threadIdx.x; i < NL * 1024; i += gridDim.x * 256) p.out[i] = f;
}
#if !MULTI_LAUNCH
__global__ void __launch_bounds__(256, 2) mega_kernel(Params p) {
  cg::grid_group grid = cg::this_grid();
  __shared__ __attribute__((aligned(16))) char smem[SMEM_BYTES];
  __shared__ uint4 xb_words;
  if (threadIdx.x == 0) xb_words = make_uint4(0u, 0u, 0u, 0u);
  __syncthreads();
  XcdBarrier xb = xcd_barrier_post((unsigned*)(p.ws + OFF_BAR), (volatile LAS unsigned*)&xb_words);
  grid.sync();
  int ph = 0;
#define RUNP(x) { if (ph++ >= STOP_PHASE) return; x; }
  RUNP(phase0(p, smem)); GSYNC(); PROBE_CHECK(); PROBE_CHECK();
  if (DBL_0) { phase0(p, smem); GSYNC(); }
  RUNP(phase0b(p)); GSYNC(); PROBE_CHECK(); PROBE_CHECK();
  for (int l = 0; l < 4; ++l) {
    RUNP(phaseA(p, l, smem)); GSYNC(); PROBE_CHECK(); PROBE_CHECK();
    if (DBL_A) { phaseA(p, l, smem); GSYNC(); }
    RUNP(phaseB(p, l, smem)); GSYNC(); PROBE_CHECK(); PROBE_CHECK();
    if (DBL_B) { phaseB(p, l, smem); GSYNC(); }
    RUNP(phaseD(p, l, smem)); GSYNC(); PROBE_CHECK(); PROBE_CHECK();
    if (DBL_D) { phaseD(p, l, smem); GSYNC(); }
    RUNP(phaseE(p, l, smem)); GSYNC(); PROBE_CHECK(); PROBE_CHECK();
    if (DBL_E) { phaseE(p, l, smem); GSYNC(); }
    RUNP(phaseF(p, l, smem)); GSYNC(); PROBE_CHECK(); PROBE_CHECK();
    RUNP(phaseG(p, l)); GSYNC(); PROBE_CHECK(); PROBE_CHECK();
    if (DBL_G) { phaseG(p, l); GSYNC(); }
    RUNP(phaseH(p, l, smem)); xcd_barrier(xb, (int)blockIdx.x < ((l < 3) ? 64 : 32)); PROBE_CHECK(); PROBE_CHECK();
    if (DBL_H) { phaseH(p, l, smem); GSYNC(); }

    RUNP(phaseI(p, l, smem)); GSYNC(); PROBE_CHECK(); PROBE_CHECK();
    if (DBL_I) { phaseI(p, l, smem); GSYNC(); }
    if (PROBE) { if (blockIdx.x == 0 && threadIdx.x == 0) ((float*)(p.ws + OFF_Y))[0] = (float)((unsigned*)(p.ws + OFF_Y))[8]; GSYNC(); probe_fill(p, 0); return; }
    RUNP(phaseJ(p, l, smem)); GSYNC(); PROBE_CHECK(); PROBE_CHECK();
    if (XSYNC) { for (int q = 0; q < 10; ++q) GSYNC(); }
    RUNP(phaseK(p, l));
    if (l < 3) GSYNC(); PROBE_CHECK();
  }
}
#else
template <int PH>
__global__ void __launch_bounds__(256, 2) phase_kernel(Params p, int l) {
  __shared__ __attribute__((aligned(16))) char smem[SMEM_BYTES];
  if (PH == 0) phase0(p, smem);
  if (PH == 1) phase0b(p);
  if (PH == 2) phaseA(p, l, smem);
  if (PH == 3) phaseB(p, l, smem);
  if (PH == 4) phaseD(p, l, smem);
  if (PH == 5) phaseE(p, l, smem);
  if (PH == 6) phaseF(p, l, smem);
  if (PH == 7) phaseG(p, l);
  if (PH == 8) phaseH(p, l, smem);
  if (PH == 9) phaseI(p, l, smem);
  if (PH == 10) phaseJ(p, l, smem);
  if (PH == 11) phaseK(p, l);
}
#endif

extern "C" void kernel_launch(void* const* d_in, const int* in_sizes, int n_in, void* d_out, int out_size, void* d_ws, size_t ws_size,
                              hipStream_t stream) {
  if (n_in < 27 || ws_size < WS_TOTAL) { fprintf(stderr, "kernel_launch: bad inputs (n_in %d, ws %zu need %zu)\n", n_in, ws_size, (size_t)WS_END); return; }
  Params p{};
  const float** pp = (const float**)&p;
  for (int i = 0; i < 27; ++i) pp[i] = (const float*)d_in[i];
  p.out = (float*)d_out;
  p.ws = (char*)d_ws;
#if !MULTI_LAUNCH
  static int grid_blocks = 0;
  if (!grid_blocks) {
    int dev = 0, cus = 0, per_cu = 0;
    hipGetDevice(&dev);
    hipDeviceGetAttribute(&cus, hipDeviceAttributeMultiprocessorCount, dev);
    hipOccupancyMaxActiveBlocksPerMultiprocessor(&per_cu, mega_kernel, 256, 0);
    if (per_cu < 1) per_cu = 1;
    if (per_cu > 2) per_cu = 2;
    grid_blocks = cus * per_cu;
  }
  (void)hipMemsetAsync((char*)d_ws + OFF_BAR, 0, XCD_BAR_WORDS * sizeof(unsigned) + 256, stream);
  void* args[] = {&p};
  hipError_t e = hipLaunchCooperativeKernel((void*)mega_kernel, dim3(grid_blocks), dim3(256), args, 0, stream);
  if (e != hipSuccess) fprintf(stderr, "cooperative launch failed: %s (grid %d)\n", hipGetErrorString(e), grid_blocks);
#else
  const dim3 g(512), b(256);
  phase_kernel<0><<<g, b, 0, stream>>>(p, 0);
  phase_kernel<1><<<g, b, 0, stream>>>(p, 0);
  for (int l = 0; l < 4; ++l) {
    phase_kernel<2><<<g, b, 0, stream>>>(p, l);
    phase_kernel<3><<<g, b, 0, stream>>>(p, l);
    phase_kernel<4><<<g, b, 0, stream>>>(p, l);
    phase_kernel<5><<<g, b, 0, stream>>>(p, l);
    phase_kernel<6><<<g, b, 0, stream>>>(p, l);
    phase_kernel<7><<<g, b, 0, stream>>>(p, l);
    phase_kernel<8><<<g, b, 0, stream>>>(p, l);
    phase_kernel<9><<<g, b, 0, stream>>>(p, l);
    phase_kernel<10><<<g, b, 0, stream>>>(p, l);
    phase_kernel<11><<<g, b, 0, stream>>>(p, l);
  }
#endif
}
```

```cpp
#include <hip/hip_runtime.h>
#include <hip/hip_cooperative_groups.h>
#include <cstdio>
namespace cg = cooperative_groups;

#ifndef MULTI_LAUNCH
#define MULTI_LAUNCH 0
#endif
#ifndef PROBE
#define PROBE 0
#endif
#define DBL_D 0
#define DBL_I 0
#define DBL_A 0
#define DBL_E 0
#define DBL_B 0
#define DBL_0 0
#define ALLWAVE_WB 1
#define BAR_DELAY 0
#define PROBE_PH 1000
#define PROBE_OFF OFF_EOUT
#define PROBE_WORDS ((size_t)NROWS_E * 512)
#define XSYNC 0
#define DBL_G 0
#define DBL_H 0
#ifndef STOP_PHASE
#define STOP_PHASE 100
#endif

typedef unsigned short bf16_t;
using bf16x8 = __attribute__((ext_vector_type(8))) short;
using f32x4 = __attribute__((ext_vector_type(4))) float;
using u32x4 = __attribute__((ext_vector_type(4))) unsigned;
#define DI __device__ __forceinline__
#define MFMA16(a, b, c) __builtin_amdgcn_mfma_f32_16x16x32_bf16((a), (b), (c), 0, 0, 0)

constexpr int NL = 16384;
constexpr int NC = 512;
constexpr int NT = NL + NC;
constexpr int DM = 1024;
constexpr int INW = 2112;
constexpr int LK = 8448;
constexpr int NROWS_E = 32768 + 512;
constexpr float ALPHA = 1.681792830507429f;
constexpr float LOG2E = 1.4426950408889634f;
constexpr float MLA_QS = 0.10206207261596577f * LOG2E;
constexpr float GQA_QS = 0.125f * LOG2E;
constexpr float GLA_QS = 0.17677669529663687f;
constexpr float LOG2_THETA = 13.287712379549449f;

constexpr int C_GQ = 0, C_GK = 128, C_GV = 256, C_GR = 512, C_GLRF = 768, C_MQA = 800, C_MKVA = 1184, C_MKR = 1440,
              C_AQ = 1472, C_AK = 1856, C_AV = 1984;

constexpr size_t al256(size_t x) { return (x + 255) & ~size_t(255); }
constexpr size_t OFF_MOD = 0;
constexpr size_t OFF_XF = OFF_MOD + al256((size_t)4 * 3 * 6144 * 4);
constexpr size_t OFF_HB = OFF_XF + al256((size_t)NT * DM * 4);
constexpr size_t OFF_CAT = OFF_HB + al256((size_t)NT * DM * 2);
constexpr size_t OFF_Y = OFF_CAT + al256((size_t)NT * DM * 2);
constexpr size_t OFF_PJ = OFF_Y + al256((size_t)NT * DM * 4);
constexpr size_t OFF_QM = OFF_PJ + al256((size_t)NT * INW * 2);
constexpr size_t OFF_KVM = OFF_QM + al256((size_t)NT * 576 * 2);
constexpr size_t OFF_KR = OFF_KVM + al256((size_t)NT * 768 * 2);
constexpr size_t OFF_QG = OFF_KR + al256((size_t)NT * 32 * 2);
constexpr size_t OFF_KG = OFF_QG + al256((size_t)NT * 384 * 2);
constexpr size_t OFF_VTM = OFF_KG + al256((size_t)NT * 128 * 2);
constexpr size_t OFF_VTG = OFF_VTM + al256((size_t)2 * 6 * 64 * LK * 2);
constexpr size_t OFF_U = OFF_VTG + al256((size_t)2 * 2 * 64 * LK * 2);
constexpr size_t OFF_SP = OFF_U + al256((size_t)2112 * 2048 * 4);
constexpr size_t OFF_DEC = OFF_SP + al256((size_t)2112 * 2048 * 4);
constexpr size_t OFF_HID = OFF_DEC + al256((size_t)2112 * 32 * 4);
constexpr size_t OFF_EOUT = OFF_HID + al256((size_t)NROWS_E * DM * 2);
constexpr size_t OFF_AFFT = OFF_EOUT + al256((size_t)NROWS_E * DM * 2);
constexpr size_t OFF_SEL = OFF_AFFT + al256((size_t)16 * NT * 4);
constexpr size_t OFF_ROWTOK = OFF_SEL + al256((size_t)16 * NT * 4);
constexpr size_t OFF_GATEV = OFF_ROWTOK + al256((size_t)NROWS_E * 4);
constexpr size_t OFF_WIN = OFF_GATEV + al256((size_t)NROWS_E * 4);
constexpr size_t OFF_WQB = OFF_WIN + al256((size_t)4 * 2176 * 1024 * 2);
constexpr size_t OFF_WKVB = OFF_WQB + al256((size_t)4 * 640 * 384 * 2);
constexpr size_t OFF_WOUT = OFF_WKVB + al256((size_t)4 * 768 * 256 * 2);
constexpr size_t OFF_WGU = OFF_WOUT + al256((size_t)4 * 1024 * 1024 * 2);
constexpr size_t OFF_WD = OFF_WGU + al256((size_t)64 * 2048 * 1024 * 2);
constexpr size_t WS_END = OFF_WD + al256((size_t)64 * 1024 * 1024 * 2);

constexpr size_t OFF_BAR = WS_END;
constexpr size_t OFF_TAB = WS_END + 16384;
constexpr size_t WS_TOTAL = OFF_TAB + 32768;
constexpr int SMEM_BYTES = 59392;

struct Params {
  const float *x, *c, *ctx, *c_ctx, *w_mod, *b_mod, *w_in, *w_gf, *b_gf, *w_gb, *b_gb, *g_gla, *g_qa, *w_qb, *g_kva, *w_kvb,
      *g_gq, *g_gk, *w_out, *ln1_g, *ln1_b, *w_router, *w_eg, *w_eu, *w_ed, *ln2_g, *ln2_b;
  float* out;
  char* ws;
};

DI int otid() { int t = threadIdx.x; asm volatile("" : "+v"(t)); return t; }
DI int obid() { int t = __builtin_amdgcn_workgroup_id_x(); asm volatile("" : "+s"(t)); return t; }
DI bf16_t f2bf(float f) { unsigned u = __float_as_uint(f); u += 0x7fffu + ((u >> 16) & 1u); return (bf16_t)(u >> 16); }
DI float bf2f(bf16_t b) { return __uint_as_float(((unsigned)b) << 16); }
typedef __bf16 hbf16x2 __attribute__((ext_vector_type(2)));
typedef float f32x2 __attribute__((ext_vector_type(2)));
DI unsigned pack2(float a, float b) { f32x2 v = {a, b}; return __builtin_bit_cast(unsigned, __builtin_convertvector(v, hbf16x2)); }
DI float wave_sum(float v) {
#pragma unroll
  for (int o = 32; o > 0; o >>= 1) v += __shfl_xor(v, o);
  return v;
}
DI float siluf(float x) { return x / (1.f + __expf(-x)); }
DI float logsigf(float z) { return fminf(z, 0.f) - log1pf(__expf(-fabsf(z))); }
DI int tok_set(int tok) { return tok < NL ? (tok >> 13) : 2; }
DI void tok_bp(int tok, int& b, int& pp) {
  if (tok < NL) { b = tok >> 13; pp = 256 + (tok & 8191); }
  else { int t = tok - NL; b = t >> 8; pp = t & 255; }
}

template <class Epi>
DI void gemm_tile(unsigned* g_badcnt, const bf16_t* __restrict__ A, int lda, const int* __restrict__ rowidx, int row0, int nvalid,
                  const bf16_t* __restrict__ Bt, int ldb, int K, bf16_t* smem, Epi epi) {
  const int tid = otid(), lane = tid & 63, wave = tid >> 6;
  const int wm = wave >> 1, wn = wave & 1;
  bf16_t* As = smem;
  bf16_t* Bs = smem + 128 * 72;
  const int lr = tid >> 3, lc = (tid & 7) * 8;
  const bf16_t* ap[4];
  const bf16_t* bp[4];
#pragma unroll
  for (int j = 0; j < 4; ++j) {
    int r = lr + 32 * j;
    int rr = r < nvalid ? r : 0;
    long grow = rowidx ? (long)rowidx[row0 + rr] : (long)(row0 + rr);
    if (rowidx) { if (grow < 0 || grow >= NT) grow = 0; }
    ap[j] = A + grow * lda + lc;
    bp[j] = Bt + (long)r * ldb + lc;
  }
  u32x4 raA[4], rbA[4], raB[4], rbB[4];
  const int nk = K >> 6;
#pragma unroll
  for (int j = 0; j < 4; ++j) { raA[j] = *(const u32x4*)ap[j]; rbA[j] = *(const u32x4*)bp[j]; }
  if (nk > 1) {
#pragma unroll
    for (int j = 0; j < 4; ++j) { raB[j] = *(const u32x4*)(ap[j] + 64); rbB[j] = *(const u32x4*)(bp[j] + 64); }
  }
  f32x4 acc[4][4];
#pragma unroll
  for (int a = 0; a < 4; ++a)
#pragma unroll
    for (int b = 0; b < 4; ++b) acc[a][b] = f32x4{0.f, 0.f, 0.f, 0.f};
  const int l15 = lane & 15, lg = lane >> 4;
  auto stage_and_compute = [&](u32x4 (&ra)[4], u32x4 (&rb)[4], int knext) {
    __syncthreads();
#pragma unroll
    for (int j = 0; j < 4; ++j) {
      *(u32x4*)(As + (lr + 32 * j) * 72 + lc) = ra[j];
      *(u32x4*)(Bs + (lr + 32 * j) * 72 + lc) = rb[j];
    }
    __syncthreads();
    if (knext < nk) {
#pragma unroll
      for (int j = 0; j < 4; ++j) { ra[j] = *(const u32x4*)(ap[j] + knext * 64); rb[j] = *(const u32x4*)(bp[j] + knext * 64); }
    }
    __builtin_amdgcn_sched_barrier(0);
#pragma unroll
    for (int ks = 0; ks < 2; ++ks) {
      bf16x8 af[4], wf[4];
#pragma unroll
      for (int mi = 0; mi < 4; ++mi) af[mi] = *(const bf16x8*)(As + (wm * 64 + mi * 16 + l15) * 72 + ks * 32 + lg * 8);
#pragma unroll
      for (int ni = 0; ni < 4; ++ni) wf[ni] = *(const bf16x8*)(Bs + (wn * 64 + ni * 16 + l15) * 72 + ks * 32 + lg * 8);
#pragma unroll
      for (int ni = 0; ni < 4; ++ni)
#pragma unroll
        for (int mi = 0; mi < 4; ++mi) acc[ni][mi] = MFMA16(wf[ni], af[mi], acc[ni][mi]);
    }
  };
  for (int kt = 0; kt < nk; kt += 2) {
    stage_and_compute(raA, rbA, kt + 2);
    if (kt + 1 >= nk) break;
    stage_and_compute(raB, rbB, kt + 3);
  }
  epi(acc, wm, wn, lane);
}

DI void tile_rowscale(const bf16_t* __restrict__ A, int lda, int row0, int ncols, float* rs) {
  const int tid = otid();
  const int r = tid >> 1, half = tid & 1;
  const int nh = ncols >> 1;
  const bf16_t* src = A + (long)(row0 + r) * lda + half * nh;
  float s = 0.f;
  for (int c = 0; c < nh; c += 8) {
    uint4 v = *(const uint4*)(src + c);
    unsigned w[4] = {v.x, v.y, v.z, v.w};
#pragma unroll
    for (int q = 0; q < 4; ++q) {
      float a = __uint_as_float(w[q] << 16), b = __uint_as_float(w[q] & 0xffff0000u);
      s += a * a + b * b;
    }
  }
  s += __shfl_xor(s, 1);
  if (half == 0) rs[r] = rsqrtf(s / (float)ncols + 1e-6f);
}

struct ConvDesc { const float* src; bf16_t* dst; const float* gs; int K, N, k0, n0, mode; };

DI ConvDesc conv_decode(const Params& p, int i) {
  bf16_t* WIN = (bf16_t*)(p.ws + OFF_WIN);
  bf16_t* WQB = (bf16_t*)(p.ws + OFF_WQB);
  bf16_t* WKVB = (bf16_t*)(p.ws + OFF_WKVB);
  bf16_t* WOUT = (bf16_t*)(p.ws + OFF_WOUT);
  bf16_t* WGU = (bf16_t*)(p.ws + OFF_WGU);
  bf16_t* WD = (bf16_t*)(p.ws + OFF_WD);
  ConvDesc d;
  d.gs = nullptr; d.mode = 0;
  if (i < 2176) { int l = i / 544, r = i % 544; d.src = p.w_in + (size_t)l * 1024 * INW; d.K = 1024; d.N = INW; d.k0 = (r / 34) * 64; d.n0 = (r % 34) * 64; d.dst = WIN + (size_t)l * 2176 * 1024; return d; }
  i -= 2176;
  if (i < 240) { int l = i / 60, r = i % 60; d.src = p.w_qb + (size_t)l * 384 * 576; d.K = 384; d.N = 576; d.k0 = (r / 10) * 64; d.n0 = (r % 10) * 64; d.dst = WQB + (size_t)l * 640 * 384; d.gs = p.g_qa + l * 384; return d; }
  i -= 240;
  if (i < 192) { int l = i / 48, r = i % 48; d.src = p.w_kvb + (size_t)l * 256 * 768; d.K = 256; d.N = 768; d.k0 = (r / 12) * 64; d.n0 = (r % 12) * 64; d.dst = WKVB + (size_t)l * 768 * 256; d.gs = p.g_kva + l * 256; return d; }
  i -= 192;
  if (i < 1024) { int l = i / 256, r = i % 256; d.src = p.w_out + (size_t)l * 1048576; d.K = 1024; d.N = 1024; d.k0 = (r / 16) * 64; d.n0 = (r % 16) * 64; d.dst = WOUT + (size_t)l * 1048576; return d; }
  i -= 1024;
  const int which = i / 16384, ii = i % 16384;
  const int m = ii / 256, r = ii % 256;
  d.K = 1024; d.N = 1024; d.k0 = (r / 16) * 64; d.n0 = (r % 16) * 64;
  if (which == 0) { d.src = p.w_eg + (size_t)m * 1048576; d.dst = WGU + (size_t)m * 2097152; d.mode = 1; }
  else if (which == 1) { d.src = p.w_eu + (size_t)m * 1048576; d.dst = WGU + (size_t)m * 2097152; d.mode = 2; }
  else { d.src = p.w_ed + (size_t)m * 1048576; d.dst = WD + (size_t)m * 1048576; }
  return d;
}

DI void conv_load(const ConvDesc& d, int tid, f32x4 (&v)[4], float (&sc)[4]) {
  const int c4 = (tid & 15) * 4;
#pragma unroll
  for (int j = 0; j < 4; ++j) {
    const int r = (tid >> 4) + 16 * j;
    v[j] = f32x4{0.f, 0.f, 0.f, 0.f};
    if (d.n0 + c4 < d.N) v[j] = *(const f32x4*)(d.src + (size_t)(d.k0 + r) * d.N + d.n0 + c4);
    sc[j] = d.gs ? d.gs[d.k0 + r] : 1.f;
  }
}

DI void conv_store(const ConvDesc& d, int tid, const f32x4 (&v)[4], const float (&sc)[4], float* sm) {
  __syncthreads();
  const int c4 = (tid & 15) * 4;
#pragma unroll
  for (int j = 0; j < 4; ++j) {
    const int r = (tid >> 4) + 16 * j;
    sm[r * 65 + c4 + 0] = v[j][0] * sc[j];
    sm[r * 65 + c4 + 1] = v[j][1] * sc[j];
    sm[r * 65 + c4 + 2] = v[j][2] * sc[j];
    sm[r * 65 + c4 + 3] = v[j][3] * sc[j];
  }
  __syncthreads();
  const int n = tid >> 2, ks = (tid & 3) * 16;
  unsigned w[8];
#pragma unroll
  for (int q = 0; q < 8; ++q) w[q] = pack2(sm[(ks + 2 * q) * 65 + n], sm[(ks + 2 * q + 1) * 65 + n]);
  const int gn = d.n0 + n;
  int drow = gn;
  if (d.mode != 0) drow = (gn >> 5) * 64 + (gn & 31) + (d.mode == 2 ? 32 : 0);
  uint4* dp = (uint4*)(d.dst + (size_t)drow * d.K + d.k0 + ks);
  dp[0] = make_uint4(w[0], w[1], w[2], w[3]);
  dp[1] = make_uint4(w[4], w[5], w[6], w[7]);
}

DI void phase0(const Params& p, char* smem) {
  float* sm = (float*)smem;
  float* MOD = (float*)(p.ws + OFF_MOD);
  const int NCONV = 2176 + 240 + 192 + 1024 + 3 * 16384;
  const int tid = otid();
  const int G = gridDim.x;
  {
    int it = obid();
    f32x4 v[4]; float sc[4];
    ConvDesc cur = conv_decode(p, it < NCONV ? it : 0);
    if (it < NCONV) conv_load(cur, tid, v, sc);
    while (it < NCONV) {
      const int nxt = it + G;
      f32x4 vn[4]; float scn[4];
      ConvDesc dn = conv_decode(p, nxt < NCONV ? nxt : 0);
      if (nxt < NCONV) conv_load(dn, tid, vn, scn);
      conv_store(cur, tid, v, sc, sm);
#pragma unroll
      for (int j = 0; j < 4; ++j) { v[j] = vn[j]; sc[j] = scn[j]; }
      cur = dn;
      it = nxt;
    }
  }
  for (int i = obid(); i < 385; i += G) {
    if (i >= 384) {
      float* TAB = (float*)(p.ws + OFF_TAB);
      for (int q = tid; q < 128 * 24; q += 256) {
        const int pos = q / 24, f = q % 24;
        const float invf = f < 16 ? exp2f(-(float)f * (LOG2_THETA / 16.f)) : exp2f(-(float)(f - 16) * (LOG2_THETA / 8.f));
        const float ang = (float)pos * invf;
        TAB[q * 2] = cosf(ang);
        TAB[q * 2 + 1] = sinf(ang);
      }
      continue;
    }
    {
      const int l = i / 96, n0 = (i % 96) * 64;
      const int lane = tid & 63, wave = tid >> 6;
      __syncthreads();
      for (int k = tid; k < 3072; k += 256) {
        int s = k >> 10, kk = k & 1023;
        float cv = s < 2 ? p.c[s * 1024 + kk] : p.c_ctx[kk];
        sm[k] = cv / (1.f + expf(-cv));
      }
      __syncthreads();
      float a0 = 0.f, a1 = 0.f, a2 = 0.f;
      const float* w = p.w_mod + (size_t)l * 1024 * 6144 + n0 + lane;
#pragma unroll 8
      for (int k = wave * 256; k < wave * 256 + 256; ++k) {
        float wv = w[(size_t)k * 6144];
        a0 += sm[k] * wv; a1 += sm[1024 + k] * wv; a2 += sm[2048 + k] * wv;
      }
      float* part = sm + 3072;
      part[(wave * 3 + 0) * 64 + lane] = a0;
      part[(wave * 3 + 1) * 64 + lane] = a1;
      part[(wave * 3 + 2) * 64 + lane] = a2;
      __syncthreads();
      if (tid < 192) {
        int s = tid >> 6, ln = tid & 63;
        float v2 = part[(0 * 3 + s) * 64 + ln] + part[(1 * 3 + s) * 64 + ln] + part[(2 * 3 + s) * 64 + ln] + part[(3 * 3 + s) * 64 + ln];
        MOD[(size_t)(l * 3 + s) * 6144 + n0 + ln] = v2 + p.b_mod[l * 6144 + n0 + ln];
      }
    }
  }
}

DI void phase0b(const Params& p) {
  float* XF = (float*)(p.ws + OFF_XF);
  bf16_t* HB = (bf16_t*)(p.ws + OFF_HB);
  const float* MOD = (const float*)(p.ws + OFF_MOD);
  const int total = NT * 256;
  for (int idx = obid() * 256 + otid(); idx < total; idx += gridDim.x * 256) {
    int tok = idx >> 8, c = (idx & 255) * 4;
    const float* src = tok < NL ? p.x + (size_t)tok * 1024 : p.ctx + (size_t)(tok - NL) * 1024;
    float4 v = *(const float4*)(src + c);
    *(float4*)(XF + (size_t)tok * 1024 + c) = v;
    const float* md = MOD + (size_t)tok_set(tok) * 6144;
    float4 sh = *(const float4*)(md + c), sc = *(const float4*)(md + 1024 + c);
    uint2 o;
    o.x = pack2(v.x * (1.f + sc.x) + sh.x, v.y * (1.f + sc.y) + sh.y);
    o.y = pack2(v.z * (1.f + sc.z) + sh.z, v.w * (1.f + sc.w) + sh.w);
    *(uint2*)(HB + (size_t)tok * 1024 + c) = o;
  }
}

DI void phaseA(const Params& p, int l, char* smem) {
  const bf16_t* HB = (const bf16_t*)(p.ws + OFF_HB);
  const bf16_t* WIN = (const bf16_t*)(p.ws + OFF_WIN) + (size_t)l * 2176 * 1024;
  bf16_t* PJ = (bf16_t*)(p.ws + OFF_PJ);
  const int ntiles = 132 * 17;
  const int bid_ = obid();
  const bool xmap = (gridDim.x == 512);
  const int xn = xmap ? ((132 - (bid_ & 7) + 7) >> 3) * 17 : 0;
  for (int t_ = xmap ? (bid_ >> 3) : bid_; t_ < (xmap ? xn : ntiles); t_ += (xmap ? 64 : (int)gridDim.x)) {
    const int mt = xmap ? (bid_ & 7) + 8 * (t_ / 17) : t_ / 17, nt = t_ % 17;
    gemm_tile((unsigned*)(p.ws + OFF_Y) + 8, HB, 1024, nullptr, mt * 128, 128, WIN + (size_t)nt * 128 * 1024, 1024, 1024, (bf16_t*)smem,
              [&](f32x4 (&acc)[4][4], int wm, int wn, int lane) {
#pragma unroll
                for (int ni = 0; ni < 4; ++ni) {
                  int n = nt * 128 + wn * 64 + ni * 16 + (lane >> 4) * 4;
                  if (n < INW) {
#pragma unroll
                    for (int mi = 0; mi < 4; ++mi) {
                      int m = mt * 128 + wm * 64 + mi * 16 + (lane & 15);
                      uint2 o;
                      o.x = pack2(acc[ni][mi][0], acc[ni][mi][1]);
                      o.y = pack2(acc[ni][mi][2], acc[ni][mi][3]);
                      *(uint2*)(PJ + (size_t)m * INW + n) = o;
                    }
                  }
                }
              });
  }
}

DI void gla_la8(const bf16_t* __restrict__ PJ, int tok, int dir, const float* __restrict__ W, const float* __restrict__ bias, int h, int d0,
                float* out8) {
  const bf16_t* g = PJ + (size_t)tok * INW + C_GLRF + dir * 16;
  uint4 g0 = *(const uint4*)g, g1 = *(const uint4*)(g + 8);
  unsigned gw[8] = {g0.x, g0.y, g0.z, g0.w, g1.x, g1.y, g1.z, g1.w};
  float a[8];
#pragma unroll
  for (int q = 0; q < 8; ++q) a[q] = bias[h * 32 + d0 + q];
#pragma unroll
  for (int r = 0; r < 16; ++r) {
    float gv = (r & 1) ? __uint_as_float(gw[r >> 1] & 0xffff0000u) : __uint_as_float(gw[r >> 1] << 16);
    const float* wr = W + r * 128 + h * 32 + d0;
#pragma unroll
    for (int q = 0; q < 8; ++q) a[q] += gv * wr[q];
  }
#pragma unroll
  for (int q = 0; q < 8; ++q) out8[q] = logsigf(a[q]) * (1.f / 16.f);
}

DI void gla_cumsum(const bf16_t* __restrict__ PJ, int tok0, int dir, const float* __restrict__ W, const float* __restrict__ bias, int h,
                   float* la, float* blast, float* segtot) {
  const int tid = otid();
  {
    const int t = tid >> 2, d0 = (tid & 3) * 8;
    float o8[8];
    gla_la8(PJ, tok0 + t, dir, W, bias, h, d0, o8);
#pragma unroll
    for (int q = 0; q < 8; ++q) la[t * 32 + d0 + q] = o8[q];
  }
  __syncthreads();
  const int d = tid & 31, seg = tid >> 5;
  float vals[8];
  float run = 0.f;
#pragma unroll
  for (int k = 0; k < 8; ++k) {
    const int o = seg * 8 + k;
    const int t = dir ? 63 - o : o;
    run += la[t * 32 + d];
    vals[k] = run;
  }
  segtot[seg * 32 + d] = run;
  __syncthreads();
  float off = 0.f;
#pragma unroll
  for (int sgi = 0; sgi < 7; ++sgi) off += (sgi < seg) ? segtot[sgi * 32 + d] : 0.f;
#pragma unroll
  for (int k = 0; k < 8; ++k) {
    const int o = seg * 8 + k;
    const int t = dir ? 63 - o : o;
    la[t * 32 + d] = vals[k] + off;
  }
  if (seg == 7) blast[d] = run + off;
  __syncthreads();
}

DI int chunk_tok0(int cidx) { return cidx < 256 ? cidx * 64 : NL + (cidx - 256) * 64; }

DI void gla_u_item(const Params& p, int l, int item, char* smem) {
  const bf16_t* PJ = (const bf16_t*)(p.ws + OFF_PJ);
  float* U = (float*)(p.ws + OFF_U);
  float* DEC = (float*)(p.ws + OFF_DEC);
  const int dir = item & 1, h = (item >> 1) & 3, cidx = item >> 3;
  const int tok0 = chunk_tok0(cidx);
  const float* W = (dir ? p.w_gb : p.w_gf) + l * 16 * 128;
  const float* bias = (dir ? p.b_gb : p.b_gf) + l * 128;
  float* la = (float*)smem;
  float* blast = la + 2048;
  float* segtot = blast + 32;
  bf16_t* VT = (bf16_t*)(segtot + 256);
  bf16_t* KT = VT + 64 * 72;
  const int tid = otid(), lane = tid & 63, wave = tid >> 6;
  const int l15 = lane & 15, lg = lane >> 4;
  __syncthreads();
  gla_cumsum(PJ, tok0, dir, W, bias, h, la, blast, segtot);
  {
    const int t = tid >> 2, d0 = (tid & 3) * 8;
    const bf16_t* kp = PJ + (size_t)(tok0 + t) * INW + C_GK + h * 32 + d0;
    const u32x4 kr = *(const u32x4*)kp;
#pragma unroll
    for (int q = 0; q < 8; ++q) {
      const unsigned wd = kr[q >> 1];
      const float kv = (q & 1) ? __uint_as_float(wd & 0xffff0000u) : __uint_as_float(wd << 16);
      KT[(d0 + q) * 72 + t] = f2bf(kv * __expf(blast[d0 + q] - la[t * 32 + d0 + q]));
    }
    const int e0 = (tid & 3) * 16;
    const bf16_t* vp = PJ + (size_t)(tok0 + t) * INW + C_GV + h * 64 + e0;
    const u32x4 v0 = *(const u32x4*)vp, v1 = *(const u32x4*)(vp + 8);
#pragma unroll
    for (int q = 0; q < 8; ++q) {
      const unsigned w0 = v0[q >> 1], w1 = v1[q >> 1];
      VT[(e0 + q) * 72 + t] = (bf16_t)((q & 1) ? (w0 >> 16) : (w0 & 0xffffu));
      VT[(e0 + 8 + q) * 72 + t] = (bf16_t)((q & 1) ? (w1 >> 16) : (w1 & 0xffffu));
    }
  }
  __syncthreads();
  f32x4 acc[2] = {f32x4{0.f, 0.f, 0.f, 0.f}, f32x4{0.f, 0.f, 0.f, 0.f}};
#pragma unroll
  for (int s2 = 0; s2 < 2; ++s2) {
    const bf16x8 vf = *(const bf16x8*)(VT + (wave * 16 + l15) * 72 + s2 * 32 + lg * 8);
#pragma unroll
    for (int dt = 0; dt < 2; ++dt) {
      const bf16x8 kf = *(const bf16x8*)(KT + (dt * 16 + l15) * 72 + s2 * 32 + lg * 8);
      acc[dt] = MFMA16(vf, kf, acc[dt]);
    }
  }
#pragma unroll
  for (int dt = 0; dt < 2; ++dt) {
    float* up = U + (size_t)item * 2048 + (dt * 16 + l15) * 64 + wave * 16 + lg * 4;
    *(float4*)up = make_float4(acc[dt][0], acc[dt][1], acc[dt][2], acc[dt][3]);
  }
  if (tid < 32) DEC[item * 32 + tid] = __expf(blast[tid]);
}

DI void prep_item(const Params& p, int l, int tile, char* smem) {
  const bf16_t* PJ = (const bf16_t*)(p.ws + OFF_PJ);
  bf16_t* QG = (bf16_t*)(p.ws + OFF_QG);
  bf16_t* KG = (bf16_t*)(p.ws + OFF_KG);
  bf16_t* KR = (bf16_t*)(p.ws + OFF_KR);
  bf16_t* VTG = (bf16_t*)(p.ws + OFF_VTG);
  const float* TAB = (const float*)(p.ws + OFF_TAB);
  const int tok0 = tile * 64;
  const int tid = otid(), lane = tid & 63, wave = tid >> 6;
  const bool lat = tok0 < NL;
  __syncthreads();
  for (int tt = wave; tt < 64; tt += 4) {
    const int tok = tok0 + tt;
    const bf16_t* row = PJ + (size_t)tok * INW;
    float v[8];
#pragma unroll
    for (int hh = 0; hh < 8; ++hh) v[hh] = bf2f(row[(hh < 6 ? C_AQ + hh * 64 : C_AK + (hh - 6) * 64) + lane]);
    float kr = bf2f(row[C_MKR + (lane & 31)]);
    const int t = tok & 8191;
    float csg = 1.f, sng = 0.f, csm = 1.f, snm = 0.f;
    if (lat) {
      const float2 a = *(const float2*)(TAB + ((lane < 32 ? (t >> 6) : (t & 63)) * 24 + (lane & 15)) * 2);
      csg = a.x; sng = a.y;
      const int r = lane & 31;
      const float2 m2 = *(const float2*)(TAB + (((r >> 4) ? (t & 63) : (t >> 6)) * 24 + 16 + (r & 7)) * 2);
      csm = m2.x; snm = m2.y;
    }
    const float gq = p.g_gq[l * 64 + lane], gk = p.g_gk[l * 64 + lane];
#pragma unroll
    for (int hh = 0; hh < 8; ++hh) {
      const float ss = wave_sum(v[hh] * v[hh]);
      const float rn = rsqrtf(ss * (1.f / 64.f) + 1e-6f);
      float y = v[hh] * rn * (hh < 6 ? gq : gk);
      const float partner = __shfl_xor(y, 16);
      y = ((lane >> 4) & 1) ? (partner * sng + y * csg) : (y * csg - partner * sng);
      if (hh < 6) QG[(size_t)tok * 384 + hh * 64 + lane] = f2bf(y * GQA_QS);
      else KG[(size_t)tok * 128 + (hh - 6) * 64 + lane] = f2bf(y);
    }
    {
      const float partner = __shfl_xor(kr, 8);
      const int r = lane & 31;
      kr = ((r >> 3) & 1) ? (partner * snm + kr * csm) : (kr * csm - partner * snm);
      if (lane < 32) KR[(size_t)tok * 32 + r] = f2bf(kr);
    }
  }
  bf16_t* sm = (bf16_t*)smem;
  for (int c = tid; c < 64 * 16; c += 256) {
    int t = c >> 4, cc = (c & 15) * 8;
    *(uint4*)(sm + t * 136 + cc) = *(const uint4*)(PJ + (size_t)(tok0 + t) * INW + C_AV + cc);
  }
  __syncthreads();
  {
    int b, pp;
    tok_bp(tok0, b, pp);
    const int c = tid >> 1, half = tid & 1;
    const int kvh = c >> 6, dv = c & 63;
    unsigned w[16];
#pragma unroll
    for (int q = 0; q < 16; ++q) {
      unsigned lo = sm[(half * 32 + 2 * q) * 136 + c], hi = sm[(half * 32 + 2 * q + 1) * 136 + c];
      w[q] = lo | (hi << 16);
    }
    uint4* d = (uint4*)(VTG + ((size_t)((b * 2 + kvh) * 64 + dv)) * LK + pp + half * 32);
    d[0] = make_uint4(w[0], w[1], w[2], w[3]);
    d[1] = make_uint4(w[4], w[5], w[6], w[7]);
    d[2] = make_uint4(w[8], w[9], w[10], w[11]);
    d[3] = make_uint4(w[12], w[13], w[14], w[15]);
  }
}

DI void phaseB(const Params& p, int l, char* smem) {
  const bf16_t* PJ = (const bf16_t*)(p.ws + OFF_PJ);
  const bf16_t* WQB = (const bf16_t*)(p.ws + OFF_WQB) + (size_t)l * 640 * 384;
  const bf16_t* WKVB = (const bf16_t*)(p.ws + OFF_WKVB) + (size_t)l * 768 * 256;
  bf16_t* QM = (bf16_t*)(p.ws + OFF_QM);
  bf16_t* KVM = (bf16_t*)(p.ws + OFF_KVM);
  bf16_t* VTM = (bf16_t*)(p.ws + OFF_VTM);
  float* rs = (float*)(smem + 2 * 128 * 72 * 2);
  const float* TAB = (const float*)(p.ws + OFF_TAB);
  const int N_G2 = 132 * 5, N_G3 = 132 * 6, N_PREP = 264, N_U = 2112;
  const int total = N_G2 + N_G3 + N_PREP + N_U;
  for (int it = obid(); it < total; it += gridDim.x) {
    int id = it;
    if (id < N_G2) {
      const int mt = id / 5, nt = id % 5;
      __syncthreads();
      tile_rowscale(PJ + C_MQA, INW, mt * 128, 384, rs);
      gemm_tile((unsigned*)(p.ws + OFF_Y) + 8, PJ + C_MQA, INW, nullptr, mt * 128, 128, WQB + (size_t)nt * 128 * 384, 384, 384, (bf16_t*)smem,
                [&](f32x4 (&acc)[4][4], int wm, int wn, int lane) {
#pragma unroll
                  for (int ni = 0; ni < 4; ++ni) {
                    const int n = nt * 128 + wn * 64 + ni * 16 + (lane >> 4) * 4;
                    const int d = n % 96;
#pragma unroll
                    for (int mi = 0; mi < 4; ++mi) {
                      const int ml = wm * 64 + mi * 16 + (lane & 15);
                      const int tok = mt * 128 + ml;
                      const float rsc = rs[ml];
                      float v[4], pr[4];
#pragma unroll
                      for (int i = 0; i < 4; ++i) { v[i] = acc[ni][mi][i] * rsc; pr[i] = __shfl_xor(v[i], 32); }
                      if (d >= 64 && tok < NL && n < 576) {
                        const int r = d - 64;
                        const int t = tok & 8191;
                        const int pos = (r >> 4) ? (t & 63) : (t >> 6);
                        const bool second = (r >> 3) & 1;
                        const float* tb = TAB + (pos * 24 + 16 + (r & 7)) * 2;
                        const float4 c01 = *(const float4*)tb, c23 = *(const float4*)(tb + 4);
                        const float csv[4] = {c01.x, c01.z, c23.x, c23.z}, snv[4] = {c01.y, c01.w, c23.y, c23.w};
#pragma unroll
                        for (int i = 0; i < 4; ++i) v[i] = second ? (pr[i] * snv[i] + v[i] * csv[i]) : (v[i] * csv[i] - pr[i] * snv[i]);
                      }
                      if (n < 576) {
                        uint2 o;
                        o.x = pack2(v[0] * MLA_QS, v[1] * MLA_QS);
                        o.y = pack2(v[2] * MLA_QS, v[3] * MLA_QS);
                        *(uint2*)(QM + (size_t)tok * 576 + n) = o;
                      }
                    }
                  }
                });
      continue;
    }
    id -= N_G2;
    if (id < N_G3) {
      const int mt = id / 6, nt = id % 6;
      __syncthreads();
      tile_rowscale(PJ + C_MKVA, INW, mt * 128, 256, rs);
      gemm_tile((unsigned*)(p.ws + OFF_Y) + 8, PJ + C_MKVA, INW, nullptr, mt * 128, 128, WKVB + (size_t)nt * 128 * 256, 256, 256, (bf16_t*)smem,
                [&](f32x4 (&acc)[4][4], int wm, int wn, int lane) {
#pragma unroll
                  for (int ni = 0; ni < 4; ++ni) {
                    const int cl = ni * 16 + (lane >> 4) * 4;
#pragma unroll
                    for (int mi = 0; mi < 4; ++mi) {
                      const int ml = wm * 64 + mi * 16 + (lane & 15);
                      const int tok = mt * 128 + ml;
                      const float rsc = rs[ml];
                      float v[4];
#pragma unroll
                      for (int i = 0; i < 4; ++i) v[i] = acc[ni][mi][i] * rsc;
                      if (wn == 0) {
                        uint2 o;
                        o.x = pack2(v[0], v[1]);
                        o.y = pack2(v[2], v[3]);
                        *(uint2*)(KVM + (size_t)tok * 768 + nt * 128 + cl) = o;
                      } else {
                        int b, pp;
                        tok_bp(tok, b, pp);
                        bf16_t* vt = VTM + ((size_t)((b * 6 + nt) * 64 + cl)) * LK + pp;
#pragma unroll
                        for (int i = 0; i < 4; ++i) vt[(size_t)i * LK] = f2bf(v[i]);
                      }
                    }
                  }
                });
      continue;
    }
    id -= N_G3;
    if (id < N_PREP) { prep_item(p, l, id, smem); continue; }
    id -= N_PREP;
    gla_u_item(p, l, id, smem);
  }
}

template <bool MLA>
DI void attn_item(const bf16_t* __restrict__ Qb, int ldq, const bf16_t* __restrict__ Kb, int ldk, const bf16_t* __restrict__ KRb,
                  const bf16_t* __restrict__ Vt, int b, int qtok0, int ntiles, bool ctxq, bf16_t* __restrict__ outp, bf16_t* smem) {
  constexpr int DQK = MLA ? 96 : 64;
  constexpr int KST = DQK + 8;
  constexpr int CPR = DQK / 8;
  constexpr int NKC = 64 * CPR / 256;
  constexpr int NKS = DQK / 32;
  constexpr int BUF = 64 * KST + 64 * 72;
  const int tid = otid(), lane = tid & 63, wave = tid >> 6;
  const int l15 = lane & 15, lg = lane >> 4;
  bf16x8 qf[2][NKS];
#pragma unroll
  for (int mi = 0; mi < 2; ++mi)
#pragma unroll
    for (int ks = 0; ks < NKS; ++ks)
      qf[mi][ks] = *(const bf16x8*)(Qb + (size_t)(qtok0 + wave * 32 + mi * 16 + l15) * ldq + ks * 32 + lg * 8);
  int krow[NKC], kcc[NKC];
#pragma unroll
  for (int j = 0; j < NKC; ++j) { int c = tid + 256 * j; krow[j] = c / CPR; kcc[j] = c % CPR; }
  u32x4 rk[NKC], rv[2];
  auto load_tile = [&](int kt) {
    int ktok0;
    if (ctxq || kt < 4) ktok0 = NL + b * 256 + kt * 64; else ktok0 = b * 8192 + (kt - 4) * 64;
#pragma unroll
    for (int j = 0; j < NKC; ++j) {
      const bf16_t* src;
      if (MLA && kcc[j] >= 8) src = KRb + (size_t)(ktok0 + krow[j]) * 32 + (kcc[j] - 8) * 8;
      else src = Kb + (size_t)(ktok0 + krow[j]) * ldk + kcc[j] * 8;
      rk[j] = *(const u32x4*)src;
    }
#pragma unroll
    for (int j = 0; j < 2; ++j) {
      int c = tid + 256 * j;
      rv[j] = *(const u32x4*)(Vt + (size_t)(c >> 3) * LK + kt * 64 + (c & 7) * 8);
    }
  };
  auto store_tile = [&](int buf) {
    bf16_t* Ks = smem + buf * BUF;
    bf16_t* Vs = Ks + 64 * KST;
#pragma unroll
    for (int j = 0; j < NKC; ++j) *(u32x4*)(Ks + krow[j] * KST + kcc[j] * 8) = rk[j];
#pragma unroll
    for (int j = 0; j < 2; ++j) { int c = tid + 256 * j; *(u32x4*)(Vs + (c >> 3) * 72 + (c & 7) * 8) = rv[j]; }
  };
  f32x4 o[4][2];
#pragma unroll
  for (int a = 0; a < 4; ++a)
#pragma unroll
    for (int c = 0; c < 2; ++c) o[a][c] = f32x4{0.f, 0.f, 0.f, 0.f};
  float mrun[2] = {-1e30f, -1e30f}, lrun[2] = {0.f, 0.f};
  __syncthreads();
  load_tile(0);
  store_tile(0);
  if (ntiles > 1) load_tile(1);
  __syncthreads();
  for (int kt = 0; kt < ntiles; ++kt) {
    if (kt + 1 < ntiles) {
      store_tile((kt + 1) & 1);
      if (kt + 2 < ntiles) load_tile(kt + 2);
    }
    const bf16_t* Ks = smem + (kt & 1) * BUF;
    const bf16_t* Vs = Ks + 64 * KST;
    f32x4 s[2][4];
#pragma unroll
    for (int mi = 0; mi < 2; ++mi)
#pragma unroll
      for (int ni = 0; ni < 4; ++ni) s[mi][ni] = f32x4{0.f, 0.f, 0.f, 0.f};
#pragma unroll
    for (int ks = 0; ks < NKS; ++ks) {
#pragma unroll
      for (int ni = 0; ni < 4; ++ni) {
        bf16x8 kf = *(const bf16x8*)(Ks + (ni * 16 + l15) * KST + ks * 32 + lg * 8);
#pragma unroll
        for (int mi = 0; mi < 2; ++mi) s[mi][ni] = MFMA16(kf, qf[mi][ks], s[mi][ni]);
      }
    }
    float pmx[2];
    bool need = false;
#pragma unroll
    for (int mi = 0; mi < 2; ++mi) {
      float mx = fmaxf(fmaxf(s[mi][0][0], s[mi][0][1]), fmaxf(s[mi][0][2], s[mi][0][3]));
#pragma unroll
      for (int ni = 1; ni < 4; ++ni) mx = fmaxf(mx, fmaxf(fmaxf(s[mi][ni][0], s[mi][ni][1]), fmaxf(s[mi][ni][2], s[mi][ni][3])));
      pmx[mi] = mx;
      need = need || (mx > mrun[mi] + 8.f);
    }
    if (__any(need)) {
#pragma unroll
      for (int mi = 0; mi < 2; ++mi) {
        float mx = pmx[mi];
        mx = fmaxf(mx, __shfl_xor(mx, 16));
        mx = fmaxf(mx, __shfl_xor(mx, 32));
        const float mnew = fmaxf(mrun[mi], mx);
        const float alpha = __builtin_amdgcn_exp2f(mrun[mi] - mnew);
        mrun[mi] = mnew;
        lrun[mi] *= alpha;
#pragma unroll
        for (int nd = 0; nd < 4; ++nd)
#pragma unroll
          for (int i = 0; i < 4; ++i) o[nd][mi][i] *= alpha;
      }
    }
    bf16x8 pf[2][2];
#pragma unroll
    for (int mi = 0; mi < 2; ++mi) {
      const float mref = mrun[mi];
      f32x2 rs2 = {0.f, 0.f};
#pragma unroll
      for (int ni = 0; ni < 4; ++ni) {
        f32x2 p01 = {__builtin_amdgcn_exp2f(s[mi][ni][0] - mref), __builtin_amdgcn_exp2f(s[mi][ni][1] - mref)};
        f32x2 p23 = {__builtin_amdgcn_exp2f(s[mi][ni][2] - mref), __builtin_amdgcn_exp2f(s[mi][ni][3] - mref)};
        rs2 += p01;
        rs2 += p23;
        s[mi][ni][0] = p01[0]; s[mi][ni][1] = p01[1]; s[mi][ni][2] = p23[0]; s[mi][ni][3] = p23[1];
      }
      lrun[mi] += rs2[0] + rs2[1];
#pragma unroll
      for (int s2 = 0; s2 < 2; ++s2) {
        u32x4 u = {pack2(s[mi][2 * s2][0], s[mi][2 * s2][1]), pack2(s[mi][2 * s2][2], s[mi][2 * s2][3]),
                   pack2(s[mi][2 * s2 + 1][0], s[mi][2 * s2 + 1][1]), pack2(s[mi][2 * s2 + 1][2], s[mi][2 * s2 + 1][3])};
        pf[mi][s2] = __builtin_bit_cast(bf16x8, u);
      }
    }
#pragma unroll
    for (int s2 = 0; s2 < 2; ++s2) {
#pragma unroll
      for (int nd = 0; nd < 4; ++nd) {
        const bf16_t* vb = Vs + (nd * 16 + l15) * 72 + 32 * s2 + 4 * lg;
        uint2 lo = *(const uint2*)vb, hi = *(const uint2*)(vb + 16);
        u32x4 u = {lo.x, lo.y, hi.x, hi.y};
        bf16x8 vf = __builtin_bit_cast(bf16x8, u);
#pragma unroll
        for (int mi = 0; mi < 2; ++mi) o[nd][mi] = MFMA16(vf, pf[mi][s2], o[nd][mi]);
      }
    }
    __syncthreads();
  }
#pragma unroll
  for (int mi = 0; mi < 2; ++mi) {
    float lt = lrun[mi];
    lt += __shfl_xor(lt, 16);
    lt += __shfl_xor(lt, 32);
    const float inv = 1.f / lt;
    const int q = qtok0 + wave * 32 + mi * 16 + l15;
#pragma unroll
    for (int nd = 0; nd < 4; ++nd) {
      uint2 w;
      w.x = pack2(o[nd][mi][0] * inv, o[nd][mi][1] * inv);
      w.y = pack2(o[nd][mi][2] * inv, o[nd][mi][3] * inv);
      *(uint2*)(outp + (size_t)q * 1024 + nd * 16 + lg * 4) = w;
    }
  }
}

DI void attn_dispatch(const Params& p, int combo, int qt, bool ctxq, char* smem) {
  const bf16_t* QM = (const bf16_t*)(p.ws + OFF_QM);
  const bf16_t* KVM = (const bf16_t*)(p.ws + OFF_KVM);
  const bf16_t* KR = (const bf16_t*)(p.ws + OFF_KR);
  const bf16_t* QG = (const bf16_t*)(p.ws + OFF_QG);
  const bf16_t* KG = (const bf16_t*)(p.ws + OFF_KG);
  const bf16_t* VTM = (const bf16_t*)(p.ws + OFF_VTM);
  const bf16_t* VTG = (const bf16_t*)(p.ws + OFF_VTG);
  bf16_t* CAT = (bf16_t*)(p.ws + OFF_CAT);
  const bool mla = combo < 12;
  const int c2 = mla ? combo : combo - 12;
  const int b = c2 / 6, h = c2 % 6;
  const int qtok0 = ctxq ? NL + b * 256 + qt * 128 : b * 8192 + qt * 128;
  const int ntiles = ctxq ? 4 : 132;
  if (mla)
    attn_item<true>(QM + h * 96, 576, KVM + h * 128, 768, KR, VTM + (size_t)((b * 6 + h) * 64) * LK, b, qtok0, ntiles, ctxq,
                    CAT + 256 + h * 64, (bf16_t*)smem);
  else {
    const int kvh = h / 3;
    attn_item<false>(QG + h * 64, 384, KG + kvh * 64, 128, nullptr, VTG + (size_t)((b * 2 + kvh) * 64) * LK, b, qtok0, ntiles, ctxq,
                     CAT + 640 + h * 64, (bf16_t*)smem);
  }
}

DI void scan_item(const Params& p, int item) {
  const float* __restrict__ U = (const float*)(p.ws + OFF_U);
  const float* __restrict__ DEC = (const float*)(p.ws + OFF_DEC);
  float* __restrict__ SP = (float*)(p.ws + OFF_SP);
  const int eb = item & 7, dir = (item >> 3) & 1, h = (item >> 4) & 3, b = item >> 6;
  const int idx = eb * 256 + otid();
  const int d = idx >> 6;
  float s = 0.f;
#pragma unroll 4
  for (int step = 0; step < 132; ++step) {
    int cidx;
    if (step < 4) cidx = 256 + b * 4 + (dir ? 3 - step : step);
    else { int n = step - 4; cidx = b * 128 + (dir ? 127 - n : n); }
    const int it = (cidx * 4 + h) * 2 + dir;
    const float u = U[(size_t)it * 2048 + idx];
    const float dc = DEC[it * 32 + d];
    SP[(size_t)it * 2048 + idx] = s;
    s = dc * s + u;
  }
}

DI void phaseD(const Params& p, int l, char* smem) {
  const int n_ctx = (l < 3) ? 48 : 0;
  const int bid = obid(), G = gridDim.x;
  for (int it = bid; it < 128; it += G) scan_item(p, it);
  if (G == 512) {
    for (int r = 0; r < 3; ++r) attn_dispatch(p, r * 8 + (bid & 7), bid >> 3, false, smem);
  } else {
    for (int it = bid; it < 1536; it += G) attn_dispatch(p, it >> 6, it & 63, false, smem);
  }
  for (int it = (bid + 200) % G; it < n_ctx; it += G) attn_dispatch(p, it >> 1, it & 1, true, smem);
}

DI void gla_out_item(const Params& p, int l, int item, char* smem) {
  const bf16_t* PJ = (const bf16_t*)(p.ws + OFF_PJ);
  const float* SP = (const float*)(p.ws + OFF_SP);
  bf16_t* CAT = (bf16_t*)(p.ws + OFF_CAT);
  const int h = item & 3, cidx = item >> 2;
  const int tok0 = chunk_tok0(cidx);
  float* la = (float*)smem;
  float* blast = la + 2048;
  float* segtot = blast + 32;
  bf16_t* VT = (bf16_t*)(segtot + 256);
  bf16_t* QD = VT + 64 * 72;
  bf16_t* KI = QD + 64 * 40;
  bf16_t* ST = KI + 64 * 40;
  const int tid = otid(), lane = tid & 63, wave = tid >> 6;
  const int l15 = lane & 15, lg = lane >> 4;
  const int t = tid >> 2;
  __syncthreads();
  {
    const int e0 = (tid & 3) * 16;
    const bf16_t* vp = PJ + (size_t)(tok0 + t) * INW + C_GV + h * 64 + e0;
    const u32x4 v0 = *(const u32x4*)vp, v1 = *(const u32x4*)(vp + 8);
#pragma unroll
    for (int q = 0; q < 8; ++q) {
      const unsigned w0 = v0[q >> 1], w1 = v1[q >> 1];
      VT[(e0 + q) * 72 + t] = (bf16_t)((q & 1) ? (w0 >> 16) : (w0 & 0xffffu));
      VT[(e0 + 8 + q) * 72 + t] = (bf16_t)((q & 1) ? (w1 >> 16) : (w1 & 0xffffu));
    }
  }
  f32x4 o[4];
#pragma unroll
  for (int et = 0; et < 4; ++et) o[et] = f32x4{0.f, 0.f, 0.f, 0.f};
#pragma unroll 1
  for (int dir = 0; dir < 2; ++dir) {
    const float* W = (dir ? p.w_gb : p.w_gf) + l * 16 * 128;
    const float* bias = (dir ? p.b_gb : p.b_gf) + l * 128;
    __syncthreads();
    gla_cumsum(PJ, tok0, dir, W, bias, h, la, blast, segtot);
    {
      const int d0 = (tid & 3) * 8;
      const u32x4 qr = *(const u32x4*)(PJ + (size_t)(tok0 + t) * INW + C_GQ + h * 32 + d0);
      const u32x4 kr = *(const u32x4*)(PJ + (size_t)(tok0 + t) * INW + C_GK + h * 32 + d0);
      u32x4 qo, ko;
#pragma unroll
      for (int q2 = 0; q2 < 4; ++q2) {
        const float b0 = la[t * 32 + d0 + 2 * q2], b1 = la[t * 32 + d0 + 2 * q2 + 1];
        const float q0 = __uint_as_float(qr[q2] << 16), q1 = __uint_as_float(qr[q2] & 0xffff0000u);
        const float k0 = __uint_as_float(kr[q2] << 16), k1 = __uint_as_float(kr[q2] & 0xffff0000u);
        qo[q2] = pack2(q0 * GLA_QS * __expf(b0), q1 * GLA_QS * __expf(b1));
        ko[q2] = pack2(k0 * __expf(-b0), k1 * __expf(-b1));
      }
      *(u32x4*)(QD + t * 40 + d0) = qo;
      *(u32x4*)(KI + t * 40 + d0) = ko;
      const int it = (cidx * 4 + h) * 2 + dir;
      const int sd = tid >> 3, se0 = (tid & 7) * 8;
      const float* sp = SP + (size_t)it * 2048 + sd * 64 + se0;
      const float4 s0 = *(const float4*)sp, s1 = *(const float4*)(sp + 4);
      const float sv[8] = {s0.x, s0.y, s0.z, s0.w, s1.x, s1.y, s1.z, s1.w};
#pragma unroll
      for (int q = 0; q < 8; ++q) ST[(se0 + q) * 40 + sd] = f2bf(sv[q]);
    }
    __syncthreads();
    const bf16x8 qf = *(const bf16x8*)(QD + (wave * 16 + l15) * 40 + lg * 8);
    f32x4 at[4];
#pragma unroll
    for (int jt = 0; jt < 4; ++jt) {
      const bf16x8 kf = *(const bf16x8*)(KI + (jt * 16 + l15) * 40 + lg * 8);
      at[jt] = MFMA16(kf, qf, (f32x4{0.f, 0.f, 0.f, 0.f}));
      const int i = wave * 16 + l15;
#pragma unroll
      for (int r = 0; r < 4; ++r) {
        const int j = jt * 16 + lg * 4 + r;
        const bool keep = dir ? (j >= i) : (j <= i);
        at[jt][r] = keep ? at[jt][r] : 0.f;
      }
    }
#pragma unroll
    for (int s2 = 0; s2 < 2; ++s2) {
      u32x4 u = {pack2(at[2 * s2][0], at[2 * s2][1]), pack2(at[2 * s2][2], at[2 * s2][3]),
                 pack2(at[2 * s2 + 1][0], at[2 * s2 + 1][1]), pack2(at[2 * s2 + 1][2], at[2 * s2 + 1][3])};
      const bf16x8 pf = __builtin_bit_cast(bf16x8, u);
#pragma unroll
      for (int et = 0; et < 4; ++et) {
        const bf16_t* vb = VT + (et * 16 + l15) * 72 + 32 * s2 + 4 * lg;
        const uint2 lo = *(const uint2*)vb, hi = *(const uint2*)(vb + 16);
        u32x4 vu = {lo.x, lo.y, hi.x, hi.y};
        o[et] = MFMA16(__builtin_bit_cast(bf16x8, vu), pf, o[et]);
      }
    }
#pragma unroll
    for (int et = 0; et < 4; ++et) {
      const bf16x8 sf = *(const bf16x8*)(ST + (et * 16 + l15) * 40 + lg * 8);
      o[et] = MFMA16(sf, qf, o[et]);
    }
  }
  float ss = 0.f;
#pragma unroll
  for (int et = 0; et < 4; ++et)
#pragma unroll
    for (int r = 0; r < 4; ++r) ss += o[et][r] * o[et][r];
  ss += __shfl_xor(ss, 16);
  ss += __shfl_xor(ss, 32);
  const float rn = rsqrtf(ss * (1.f / 64.f) + 1e-6f);
  const int tok = tok0 + wave * 16 + l15;
#pragma unroll
  for (int et = 0; et < 4; ++et) {
    const int e = et * 16 + lg * 4;
    const uint2 rr = *(const uint2*)(PJ + (size_t)tok * INW + C_GR + h * 64 + e);
    const float4 gg = *(const float4*)(p.g_gla + l * 64 + e);
    const float r0 = __uint_as_float(rr.x << 16), r1 = __uint_as_float(rr.x & 0xffff0000u);
    const float r2 = __uint_as_float(rr.y << 16), r3 = __uint_as_float(rr.y & 0xffff0000u);
    uint2 w;
    w.x = pack2(o[et][0] * rn * gg.x * siluf(r0), o[et][1] * rn * gg.y * siluf(r1));
    w.y = pack2(o[et][2] * rn * gg.z * siluf(r2), o[et][3] * rn * gg.w * siluf(r3));
    *(uint2*)(CAT + (size_t)tok * 1024 + h * 64 + e) = w;
  }
}

DI void phaseE(const Params& p, int l, char* smem) {
  const int n = (l < 3 ? 264 : 256) * 4;
  for (int it = obid(); it < n; it += gridDim.x) gla_out_item(p, l, it, smem);
}

DI void phaseF(const Params& p, int l, char* smem) {
  const bf16_t* CAT = (const bf16_t*)(p.ws + OFF_CAT);
  const bf16_t* WOUT = (const bf16_t*)(p.ws + OFF_WOUT) + (size_t)l * 1048576;
  const float* XF = (const float*)(p.ws + OFF_XF);
  const float* MOD = (const float*)(p.ws + OFF_MOD) + (size_t)l * 3 * 6144;
  float* Y = (float*)(p.ws + OFF_Y);
  const int nmt = (l < 3 ? 132 : 128);
  const int ntiles = nmt * 8;
  const int bid_ = obid();
  const bool xmap = (gridDim.x == 512);
  const int xn = xmap ? ((nmt - (bid_ & 7) + 7) >> 3) * 8 : 0;
  for (int t_ = xmap ? (bid_ >> 3) : bid_; t_ < (xmap ? xn : ntiles); t_ += (xmap ? 64 : (int)gridDim.x)) {
    const int mt = xmap ? (bid_ & 7) + 8 * (t_ >> 3) : (t_ >> 3), nt = t_ & 7;
    gemm_tile((unsigned*)(p.ws + OFF_Y) + 8, CAT, 1024, nullptr, mt * 128, 128, WOUT + (size_t)nt * 128 * 1024, 1024, 1024, (bf16_t*)smem,
              [&](f32x4 (&acc)[4][4], int wm, int wn, int lane) {
                const float* g1 = MOD + (size_t)tok_set(mt * 128) * 6144 + 2048;
#pragma unroll
                for (int ni = 0; ni < 4; ++ni) {
                  const int n = nt * 128 + wn * 64 + ni * 16 + (lane >> 4) * 4;
                  const float4 g = *(const float4*)(g1 + n);
#pragma unroll
                  for (int mi = 0; mi < 4; ++mi) {
                    const int m = mt * 128 + wm * 64 + mi * 16 + (lane & 15);
                    const float4 xv = *(const float4*)(XF + (size_t)m * 1024 + n);
                    float4 r;
                    r.x = ALPHA * xv.x + g.x * acc[ni][mi][0];
                    r.y = ALPHA * xv.y + g.y * acc[ni][mi][1];
                    r.z = ALPHA * xv.z + g.z * acc[ni][mi][2];
                    r.w = ALPHA * xv.w + g.w * acc[ni][mi][3];
                    *(float4*)(Y + (size_t)m * 1024 + n) = r;
                  }
                }
              });
  }
}

DI void phaseG(const Params& p, int l) {
  const int ntok = (l < 3) ? NT : NL;
  const int tid_ = otid(); const int lane = tid_ & 63, wave = tid_ >> 6;
  const float* Y = (const float*)(p.ws + OFF_Y);
  float* XF = (float*)(p.ws + OFF_XF);
  bf16_t* HB = (bf16_t*)(p.ws + OFF_HB);
  float* AFFT = (float*)(p.ws + OFF_AFFT);
  const float* MODl = (const float*)(p.ws + OFF_MOD) + (size_t)l * 3 * 6144;
  const float* g = p.ln1_g + l * 1024;
  const float* bb = p.ln1_b + l * 1024;
  const float* wr = p.w_router + (size_t)l * 1024 * 16;
  const int ngroups = ntok >> 1;
  for (int tg = obid() * 4 + wave; tg < ngroups; tg += gridDim.x * 4) {
    const int tok0 = tg * 2;
    const float* md = MODl + (size_t)tok_set(tok0) * 6144;
    float v[2][16];
#pragma unroll
    for (int t = 0; t < 2; ++t)
#pragma unroll
      for (int j = 0; j < 4; ++j) {
        float4 t4 = *(const float4*)(Y + (size_t)(tok0 + t) * 1024 + j * 256 + lane * 4);
        v[t][4 * j] = t4.x; v[t][4 * j + 1] = t4.y; v[t][4 * j + 2] = t4.z; v[t][4 * j + 3] = t4.w;
      }
    float mean[2], rstd[2];
#pragma unroll
    for (int t = 0; t < 2; ++t) {
      float s = 0.f;
#pragma unroll
      for (int q = 0; q < 16; ++q) s += v[t][q];
      mean[t] = wave_sum(s) * (1.f / 1024.f);
      float qq = 0.f;
#pragma unroll
      for (int q = 0; q < 16; ++q) { float dlt = v[t][q] - mean[t]; qq += dlt * dlt; }
      rstd[t] = rsqrtf(wave_sum(qq) * (1.f / 1024.f) + 1e-6f);
    }
    float lg[32];
#pragma unroll
    for (int q = 0; q < 32; ++q) lg[q] = 0.f;
#pragma unroll
    for (int j = 0; j < 4; ++j) {
      const int col = j * 256 + lane * 4;
      const float4 g4 = *(const float4*)(g + col), b4 = *(const float4*)(bb + col);
      const float4 sh = *(const float4*)(md + 3072 + col), sc = *(const float4*)(md + 4096 + col);
      const float gg[4] = {g4.x, g4.y, g4.z, g4.w}, bv[4] = {b4.x, b4.y, b4.z, b4.w};
      const float shv[4] = {sh.x, sh.y, sh.z, sh.w}, scv[4] = {sc.x, sc.y, sc.z, sc.w};
      float hh[2][4];
#pragma unroll
      for (int t = 0; t < 2; ++t) {
        float xn[4];
#pragma unroll
        for (int c = 0; c < 4; ++c) {
          xn[c] = (v[t][4 * j + c] - mean[t]) * rstd[t] * gg[c] + bv[c];
          hh[t][c] = xn[c] * (1.f + scv[c]) + shv[c];
        }
        *(float4*)(XF + (size_t)(tok0 + t) * 1024 + col) = make_float4(xn[0], xn[1], xn[2], xn[3]);
        uint2 o;
        o.x = pack2(hh[t][0], hh[t][1]);
        o.y = pack2(hh[t][2], hh[t][3]);
        *(uint2*)(HB + (size_t)(tok0 + t) * 1024 + col) = o;
      }
#pragma unroll
      for (int c = 0; c < 4; ++c) {
        const float4* wrow = (const float4*)(wr + (size_t)(col + c) * 16);
        const float4 w0 = wrow[0], w1 = wrow[1], w2 = wrow[2], w3 = wrow[3];
        const float wv[16] = {w0.x, w0.y, w0.z, w0.w, w1.x, w1.y, w1.z, w1.w, w2.x, w2.y, w2.z, w2.w, w3.x, w3.y, w3.z, w3.w};
#pragma unroll
        for (int t = 0; t < 2; ++t)
#pragma unroll
          for (int e = 0; e < 16; ++e) lg[t * 16 + e] += hh[t][c] * wv[e];
      }
    }
#define BFLY_STEP(OFF, N) { const bool up = (lane & (OFF)) != 0; _Pragma("unroll") for (int i = 0; i < (N); ++i) { const float a = lg[i], b = lg[i + (N)]; const float send = up ? a : b, keep = up ? b : a; lg[i] = keep + __shfl_xor(send, (OFF)); } }
    BFLY_STEP(32, 16) BFLY_STEP(16, 8) BFLY_STEP(8, 4) BFLY_STEP(4, 2) BFLY_STEP(2, 1)
#undef BFLY_STEP
    const float logit = lg[0] + __shfl_xor(lg[0], 1);
    float mx = logit;
#pragma unroll
    for (int o = 16; o >= 2; o >>= 1) mx = fmaxf(mx, __shfl_xor(mx, o));
    const float ex = expf(logit - mx);
    float den = ex;
#pragma unroll
    for (int o = 16; o >= 2; o >>= 1) den += __shfl_xor(den, o);
    if ((lane & 1) == 0) AFFT[(size_t)tok0 * 16 + (lane >> 1)] = ex / den;
  }
}

DI void topk_job(const float* __restrict__ aff, int n, int cap, int rowbase, int tokbase, int* __restrict__ SELe, int* __restrict__ ROWTOK,
                 float* __restrict__ GATEV, unsigned* sm) {
  const int tid = otid();
  unsigned* hist = sm;
  unsigned* ctl = sm + 256;
  unsigned v[32];
#pragma unroll
  for (int j = 0; j < 32; ++j) { int idx = j * 256 + tid; v[j] = idx < n ? __float_as_uint(aff[(size_t)idx * 16]) : 0u; }
  __syncthreads();
  if (tid == 0) { ctl[0] = 0u; ctl[1] = (unsigned)cap; ctl[2] = 0u; }
  __syncthreads();
  unsigned prefix = 0u, remaining = (unsigned)cap;
#pragma unroll 1
  for (int pass = 0; pass < 4; ++pass) {
    const int shift = 24 - 8 * pass;
    const unsigned hm = pass == 0 ? 0u : (0xFFFFFFFFu << (shift + 8));
    hist[tid] = 0u;
    __syncthreads();
#pragma unroll
    for (int j = 0; j < 32; ++j) {
      int idx = j * 256 + tid;
      if (idx < n && (v[j] & hm) == prefix) atomicAdd(&hist[(v[j] >> shift) & 255u], 1u);
    }
    __syncthreads();
    if (tid < 64) {
      const int L = tid;
      const unsigned h0 = hist[255 - 4 * L], h1 = hist[254 - 4 * L], h2 = hist[253 - 4 * L], h3 = hist[252 - 4 * L];
      const unsigned tot = h0 + h1 + h2 + h3;
      unsigned inc = tot;
#pragma unroll
      for (int o = 1; o < 64; o <<= 1) { const unsigned t = __shfl_up(inc, o); if (L >= o) inc += t; }
      const unsigned exc = inc - tot;
      const bool last = (L == 63);
      if ((exc < remaining && inc >= remaining) || (last && inc < remaining)) {
        unsigned c = exc;
        int bin = 255 - 4 * L;
        if (c + h0 < remaining) { c += h0; bin = 254 - 4 * L;
          if (c + h1 < remaining) { c += h1; bin = 253 - 4 * L;
            if (c + h2 < remaining) { c += h2; bin = 252 - 4 * L; } } }
        ctl[0] = prefix | ((unsigned)bin << shift);
        ctl[1] = remaining - c;
      }
    }
    __syncthreads();
    prefix = ctl[0];
    remaining = ctl[1];
    if (pass < 3) __syncthreads();
  }
  const unsigned T = prefix;
  const int lane = tid & 63, wave = tid >> 6;
  unsigned* wcG = sm + 264;
  unsigned* wcE = wcG + 128;
  unsigned* baseG = wcE + 128;
  unsigned* baseE = baseG + 128;
#pragma unroll
  for (int j = 0; j < 32; ++j) {
    const int idx = j * 256 + tid;
    const bool valid = idx < n;
    const unsigned long long bg = __ballot(valid && v[j] > T), be = __ballot(valid && v[j] == T);
    if (lane == 0) { wcG[j * 4 + wave] = (unsigned)__popcll(bg); wcE[j * 4 + wave] = (unsigned)__popcll(be); }
  }
  __syncthreads();
  {
    const unsigned* src = tid < 128 ? wcG : wcE;
    unsigned* dst = tid < 128 ? baseG : baseE;
    const int t2 = tid & 127;
    unsigned a = 0u;
    for (int i = 0; i < t2; ++i) a += src[i];
    dst[t2] = a;
  }
  __syncthreads();
  const unsigned cntGT = baseG[127] + wcG[127];
  const unsigned long long ltmask = (1ull << lane) - 1ull;
#pragma unroll
  for (int j = 0; j < 32; ++j) {
    const int idx = j * 256 + tid;
    const bool valid = idx < n;
    const bool g = valid && v[j] > T, q = valid && v[j] == T;
    const unsigned long long bg = __ballot(g), be = __ballot(q);
    int row = -1;
    if (g) row = rowbase + (int)(baseG[j * 4 + wave] + (unsigned)__popcll(bg & ltmask));
    else if (q) {
      const unsigned r = baseE[j * 4 + wave] + (unsigned)__popcll(be & ltmask);
      if (r < remaining) row = rowbase + (int)(cntGT + r);
    }
    if (valid) {
      SELe[tokbase + idx] = row;
      if (row >= 0) { ROWTOK[row] = tokbase + idx; GATEV[row] = __uint_as_float(v[j]); }
    }
  }
  __syncthreads();
}

DI void phaseH(const Params& p, int l, char* smem) {
  const float* AFFT = (const float*)(p.ws + OFF_AFFT);
  int* SEL = (int*)(p.ws + OFF_SEL);
  int* ROWTOK = (int*)(p.ws + OFF_ROWTOK);
  float* GATEV = (float*)(p.ws + OFF_GATEV);
  const int njobs = (l < 3) ? 64 : 32;
  for (int job = obid(); job < njobs; job += gridDim.x) {
    if (job < 32) {
      const int e = job >> 1, b = job & 1;
      topk_job(AFFT + (size_t)(b * 8192) * 16 + e, 8192, 1024, (e * 2 + b) * 1024, b * 8192, SEL + (size_t)e * NT, ROWTOK, GATEV, (unsigned*)smem);
    } else {
      const int j2 = job - 32;
      const int e = j2 >> 1, b = j2 & 1;
      topk_job(AFFT + (size_t)(NL + b * 256) * 16 + e, 256, 32, 32768 + (e * 2 + b) * 32, NL + b * 256, SEL + (size_t)e * NT, ROWTOK, GATEV,
               (unsigned*)smem);
    }
  }
}

DI void phaseI(const Params& p, int l, char* smem) {
  const bf16_t* HB = (const bf16_t*)(p.ws + OFF_HB);
  const bf16_t* WGU = (const bf16_t*)(p.ws + OFF_WGU) + (size_t)l * 16 * 2097152;
  const int* ROWTOK = (const int*)(p.ws + OFF_ROWTOK);
  const float* GATEV = (const float*)(p.ws + OFF_GATEV);
  bf16_t* HID = (bf16_t*)(p.ws + OFF_HID);
  const int nmt = (l < 3) ? 272 : 256;
  const int ntiles = nmt * 16;
  const int bid_ = obid();
  const bool xmap = (gridDim.x == 512);
  const int nloop = xmap ? ((l < 3 && (bid_ >> 3) < 32) ? 9 : 8) : (ntiles - bid_ + (int)gridDim.x - 1) / (int)gridDim.x;
  for (int r_ = 0; r_ < nloop; ++r_) {
    int mt, nt;
    if (xmap) {
      const int x = bid_ & 7, q = bid_ >> 3;
      if (r_ < 8) { const int e2 = x + 8 * (r_ >> 2); const int sub = (r_ & 3) * 64 + q; mt = e2 * 16 + (sub >> 4); nt = sub & 15; }
      else { mt = 256 + x + 8 * (q >> 4); nt = q & 15; }
    } else { const int id = bid_ + r_ * (int)gridDim.x; mt = id >> 4; nt = id & 15; }
    int e, row0, nvalid;
    if (mt < 256) { e = mt >> 4; row0 = mt * 128; nvalid = 128; }
    else { e = mt - 256; row0 = 32768 + e * 64; nvalid = 64; }
    gemm_tile((unsigned*)(p.ws + OFF_Y) + 8, HB, 1024, ROWTOK, row0, nvalid, WGU + (size_t)e * 2097152 + (size_t)nt * 128 * 1024, 1024, 1024, (bf16_t*)smem,
              [&](f32x4 (&acc)[4][4], int wm, int wn, int lane) {
#pragma unroll
                for (int ni = 0; ni < 2; ++ni) {
                  const int f = nt * 64 + wn * 32 + ni * 16 + (lane >> 4) * 4;
#pragma unroll
                  for (int mi = 0; mi < 4; ++mi) {
                    const int ml = wm * 64 + mi * 16 + (lane & 15);
                    if (ml < nvalid) {
                      const float gt = GATEV[row0 + ml];
                      float hv[4];
#pragma unroll
                      for (int i = 0; i < 4; ++i) hv[i] = siluf(acc[ni][mi][i]) * acc[ni + 2][mi][i] * gt;
                      uint2 o;
                      o.x = pack2(hv[0], hv[1]);
                      o.y = pack2(hv[2], hv[3]);
                      *(uint2*)(HID + (size_t)(row0 + ml) * 1024 + f) = o;
                    }
                  }
                }
              });
  }
}

DI void phaseJ(const Params& p, int l, char* smem) {
  const bf16_t* HID = (const bf16_t*)(p.ws + OFF_HID);
  const bf16_t* WD = (const bf16_t*)(p.ws + OFF_WD) + (size_t)l * 16 * 1048576;
  const float* GATEV = (const float*)(p.ws + OFF_GATEV);
  bf16_t* EOUT = (bf16_t*)(p.ws + OFF_EOUT);
  const int nmt = (l < 3) ? 272 : 256;
  const int ntiles = nmt * 8;
  const int bid_ = obid();
  const bool xmap = (gridDim.x == 512);
  const int nloop = xmap ? ((l < 3 && (bid_ >> 3) < 16) ? 5 : 4) : (ntiles - bid_ + (int)gridDim.x - 1) / (int)gridDim.x;
  for (int r_ = 0; r_ < nloop; ++r_) {
    int mt, nt;
    if (xmap) {
      const int x = bid_ & 7, q = bid_ >> 3;
      if (r_ < 4) { const int e2 = x + 8 * (r_ >> 1); const int sub = (r_ & 1) * 64 + q; mt = e2 * 16 + (sub >> 3); nt = sub & 7; }
      else { mt = 256 + x + 8 * (q >> 3); nt = q & 7; }
    } else { const int id = bid_ + r_ * (int)gridDim.x; mt = id >> 3; nt = id & 7; }
    int e, row0, nvalid;
    if (mt < 256) { e = mt >> 4; row0 = mt * 128; nvalid = 128; }
    else { e = mt - 256; row0 = 32768 + e * 64; nvalid = 64; }
    gemm_tile((unsigned*)(p.ws + OFF_Y) + 8, HID, 1024, nullptr, row0, nvalid, WD + (size_t)e * 1048576 + (size_t)nt * 128 * 1024, 1024, 1024, (bf16_t*)smem,
              [&](f32x4 (&acc)[4][4], int wm, int wn, int lane) {
#pragma unroll
                for (int mi = 0; mi < 4; ++mi) {
                  const int ml = wm * 64 + mi * 16 + (lane & 15);
                  if (ml < nvalid) {
#pragma unroll
                    for (int ni = 0; ni < 4; ++ni) {
                      const int n = nt * 128 + wn * 64 + ni * 16 + (lane >> 4) * 4;
                      uint2 o;
                      o.x = pack2(acc[ni][mi][0], acc[ni][mi][1]);
                      o.y = pack2(acc[ni][mi][2], acc[ni][mi][3]);
                      *(uint2*)(EOUT + (size_t)(row0 + ml) * 1024 + n) = o;
                    }
                  }
                }
              });
  }
}

DI void phaseK(const Params& p, int l) {
  const int ntok = (l < 3) ? NT : NL;
  const int tid_ = otid(); const int lane = tid_ & 63, wave = tid_ >> 6;
  float* XF = (float*)(p.ws + OFF_XF);
  bf16_t* HB = (bf16_t*)(p.ws + OFF_HB);
  const bf16_t* EOUT = (const bf16_t*)(p.ws + OFF_EOUT);
  const int* SEL = (const int*)(p.ws + OFF_SEL);
  const float* MODl = (const float*)(p.ws + OFF_MOD) + (size_t)l * 3 * 6144;
  const float* MODn = (const float*)(p.ws + OFF_MOD) + (size_t)(l < 3 ? l + 1 : l) * 3 * 6144;
  const float* g = p.ln2_g + l * 1024;
  const float* bb = p.ln2_b + l * 1024;
  for (int tok = obid() * 4 + wave; tok < ntok; tok += gridDim.x * 4) {
    const int set = tok_set(tok);
    const float* md = MODl + (size_t)set * 6144;
    float f[16];
#pragma unroll
    for (int q = 0; q < 16; ++q) f[q] = 0.f;
    int rowv = SEL[(size_t)(lane & 15) * NT + tok];
    {
      const int* RT = (const int*)(p.ws + OFF_ROWTOK);
      const bool okr = rowv >= 0 && rowv < NROWS_E;
      const int back = okr ? RT[rowv] : -1;
      if (back != tok) rowv = -1;
    }
#pragma unroll
    for (int e = 0; e < 16; ++e) {
      const int row = __builtin_amdgcn_readlane(rowv, e);
      if (row >= 0) {
#pragma unroll
        for (int j = 0; j < 4; ++j) {
          uint2 w = *(const uint2*)(EOUT + (size_t)row * 1024 + j * 256 + lane * 4);
          f[4 * j] += __uint_as_float(w.x << 16);
          f[4 * j + 1] += __uint_as_float(w.x & 0xffff0000u);
          f[4 * j + 2] += __uint_as_float(w.y << 16);
          f[4 * j + 3] += __uint_as_float(w.y & 0xffff0000u);
        }
      }
    }
    float v[16];
#pragma unroll
    for (int j = 0; j < 4; ++j) {
      const int col = j * 256 + lane * 4;
      float4 xv = *(const float4*)(XF + (size_t)tok * 1024 + col);
      float4 g2 = *(const float4*)(md + 5120 + col);
      v[4 * j] = ALPHA * xv.x + g2.x * f[4 * j];
      v[4 * j + 1] = ALPHA * xv.y + g2.y * f[4 * j + 1];
      v[4 * j + 2] = ALPHA * xv.z + g2.z * f[4 * j + 2];
      v[4 * j + 3] = ALPHA * xv.w + g2.w * f[4 * j + 3];
    }
    float s = 0.f;
#pragma unroll
    for (int q = 0; q < 16; ++q) s += v[q];
    const float mean = wave_sum(s) * (1.f / 1024.f);
    float qq = 0.f;
#pragma unroll
    for (int q = 0; q < 16; ++q) { float dlt = v[q] - mean; qq += dlt * dlt; }
    const float rstd = rsqrtf(wave_sum(qq) * (1.f / 1024.f) + 1e-6f);
    const float* mdn = MODn + (size_t)set * 6144;
#pragma unroll
    for (int j = 0; j < 4; ++j) {
      const int col = j * 256 + lane * 4;
      const float4 g4 = *(const float4*)(g + col), b4 = *(const float4*)(bb + col);
      float4 xn;
      xn.x = (v[4 * j] - mean) * rstd * g4.x + b4.x;
      xn.y = (v[4 * j + 1] - mean) * rstd * g4.y + b4.y;
      xn.z = (v[4 * j + 2] - mean) * rstd * g4.z + b4.z;
      xn.w = (v[4 * j + 3] - mean) * rstd * g4.w + b4.w;
      if (l < 3) {
        *(float4*)(XF + (size_t)tok * 1024 + col) = xn;
        const float4 sh = *(const float4*)(mdn + col), sc = *(const float4*)(mdn + 1024 + col);
        uint2 o;
        o.x = pack2(xn.x * (1.f + sc.x) + sh.x, xn.y * (1.f + sc.y) + sh.y);
        o.y = pack2(xn.z * (1.f + sc.z) + sh.z, xn.w * (1.f + sc.w) + sh.w);
        *(uint2*)(HB + (size_t)tok * 1024 + col) = o;
      } else {
        *(float4*)(p.out + (size_t)tok * 1024 + col) = xn;
      }
    }
  }
}


DI void probe_count(const Params& p, char* smem) {
  const int* ROWTOK = (const int*)(p.ws + OFF_ROWTOK);
  float* PV = (float*)(p.ws + OFF_Y);
  if (blockIdx.x == 0) {
    unsigned* cnt = (unsigned*)smem;
    if (threadIdx.x == 0) { cnt[0] = 0; cnt[1] = 0; }
    __syncthreads();
    for (int i = threadIdx.x; i < NROWS_E; i += 256) {
      int v = ROWTOK[i];
      if (v < 0 || v >= NT) atomicAdd(&cnt[0], 1u);
      if (i >= 32768 && (v < 0 || v >= NT)) atomicAdd(&cnt[1], 1u);
    }
    __syncthreads();
    if (threadIdx.x == 0) { PV[0] = (float)cnt[0]; PV[1] = (float)cnt[1]; }
  }
}
DI void probe_fill(const Params& p, int which) {
  const float* PV = (const float*)(p.ws + OFF_Y);
  const float v = PV[which];
  for (int i = blockIdx.x * 256 + threadIdx.x; i < NL * 1024; i += gridDim.x * 256) p.out[i] = v;
}
#define XB_TMO      128
#define XB_XCNT(j)  (256  + 64 * (j))
#define XB_XSUB(j)  (1280 + 64 * (j))
#define XB_XGEN(j)  (2304 + 64 * (j))
#define XB_TOP      3328
#define XB_TOPGEN   3392
#define XCD_BAR_WORDS 3456
#define XB_SPIN_CAP (1u << 18)
#define LAS __attribute__((address_space(3)))

__device__ __forceinline__ unsigned xb_ld(unsigned* p)              { return __hip_atomic_load(p, __ATOMIC_RELAXED, __HIP_MEMORY_SCOPE_AGENT); }
__device__ __forceinline__ unsigned xb_add(unsigned* p, unsigned v) { return __hip_atomic_fetch_add(p, v, __ATOMIC_RELAXED, __HIP_MEMORY_SCOPE_AGENT); }
__device__ __forceinline__ unsigned xb_xcc_id() { return (unsigned)__builtin_amdgcn_s_getreg((3 << 11) | 20) & 0xFu; }
#define XB_SPIN(cond, bar) do { unsigned _sp = 0; while (cond) { __builtin_amdgcn_s_sleep(1); \
    if ((++_sp & 255u) == 0u) { if (xb_ld(&(bar)[XB_TMO])) break; if (_sp > XB_SPIN_CAP) { atomicAdd(&(bar)[XB_TMO], 1u); break; } } } } while (0)

struct XcdBarrier {
    unsigned* bar; unsigned x;
    volatile LAS unsigned* st;
};

__device__ __forceinline__ XcdBarrier xcd_barrier_post(unsigned* bar, volatile LAS unsigned* st) {
    XcdBarrier b; b.bar = bar; b.x = xb_xcc_id(); b.st = st;
    if (threadIdx.x == 0) (void)xb_add(&bar[XB_XCNT(b.x)], 1u);
    return b;
}
__device__ __forceinline__ void xcd_barrier_complete(unsigned* bar, unsigned x, unsigned& nloc, unsigned& nx) {
    const unsigned G = gridDim.x * gridDim.y * gridDim.z;
    unsigned sum, cnt, mine, sp = 0u;
    for (;;) {
        sum = 0u; cnt = 0u; mine = 0u;
#pragma unroll
        for (unsigned j = 0; j < 16; ++j) { const unsigned c = xb_ld(&bar[XB_XCNT(j)]); sum += c; cnt += (c > 0u) ? 1u : 0u; mine = (j == x) ? c : mine; }
        if (sum == G) break;
        __builtin_amdgcn_s_sleep(1);
        if ((++sp & 255u) == 0u) { if (xb_ld(&bar[XB_TMO])) break; if (sp > XB_SPIN_CAP) { atomicAdd(&bar[XB_TMO], 1u); break; } }
    }
    nloc = mine > 0u ? mine : 1u; nx = cnt > 0u ? cnt : 1u;
}

__device__ __forceinline__ void xcd_barrier(const XcdBarrier& b, bool stored = true) {
    if (ALLWAVE_WB && stored) { __builtin_amdgcn_fence(__ATOMIC_RELEASE, "agent"); }
    asm volatile("s_waitcnt vmcnt(0)" ::: "memory");
    __syncthreads();
    if (threadIdx.x == 0) {
        unsigned* bar = b.bar;
        __builtin_amdgcn_s_waitcnt(0);
        unsigned nloc = b.st[0], nx = b.st[1];
        if (nloc == 0u) { xcd_barrier_complete(bar, b.x, nloc, nx); b.st[0] = nloc; b.st[1] = nx; }
        if (!ALLWAVE_WB) { __builtin_amdgcn_fence(__ATOMIC_RELEASE, "agent"); asm volatile("s_waitcnt vmcnt(0)" ::: "memory"); }
        const unsigned old = xb_add(&bar[XB_XSUB(b.x)], 1u);
        const unsigned gen = old / nloc;
        if (old + 1u == (gen + 1u) * nloc) {
            if (!ALLWAVE_WB) __builtin_amdgcn_fence(__ATOMIC_RELEASE, "agent");
            asm volatile("s_waitcnt vmcnt(0)" ::: "memory");
            const unsigned og = xb_add(&bar[XB_TOP], 1u);
            const unsigned tg = og / nx;
            if (og + 1u == (tg + 1u) * nx) xb_add(&bar[XB_TOPGEN], 1u);
            else XB_SPIN(xb_ld(&bar[XB_TOPGEN]) == tg, bar);
            __builtin_amdgcn_fence(__ATOMIC_ACQUIRE, "agent");
            xb_add(&bar[XB_XGEN(b.x)], 1u);
            asm volatile("s_waitcnt vmcnt(0)" ::: "memory");
        } else {
            XB_SPIN(xb_ld(&bar[XB_XGEN(b.x)]) == gen, bar);
            __builtin_amdgcn_fence(__ATOMIC_ACQUIRE, "agent");
            asm volatile("s_waitcnt vmcnt(0)" ::: "memory");
        }
    }
    if (BAR_DELAY && threadIdx.x == 0) { for (int q = 0; q < BAR_DELAY; ++q) __builtin_amdgcn_s_sleep(127); }
    __syncthreads();
}

#define GSYNC() xcd_barrier(xb)
#define PROBE_CHECK() { if (ph == PROBE_PH) { probe_sum(p, (const unsigned*)(p.ws + PROBE_OFF), PROBE_WORDS); GSYNC(); probe_out(p); return; } }

DI void probe_sum(const Params& p, const unsigned* buf, size_t nwords) {
  unsigned acc = 0u;
  for (size_t i = (size_t)blockIdx.x * 256 + threadIdx.x; i < nwords; i += (size_t)gridDim.x * 256) acc += buf[i] * 2654435761u + (buf[i] >> 7);
  for (int o = 32; o > 0; o >>= 1) acc += __shfl_xor(acc, o);
  if ((threadIdx.x & 63) == 0) atomicAdd((unsigned*)(p.ws + OFF_BAR) + XCD_BAR_WORDS, acc);
}
DI void probe_out(const Params& p) {
  const unsigned v = *((const unsigned*)(p.ws + OFF_BAR) + XCD_BAR_WORDS);
  const float f = (float)(v & 0xFFFFu) * (1.f / 65536.f);
  for (int i = blockIdx.x * 256 + threadIdx.x; i < NL * 1024; i += gridDim.x * 256) p.out[i] = f;
}
#if !MULTI_LAUNCH
__global__ void __launch_bounds__(256, 2) mega_kernel(Params p) {
  cg::grid_group grid = cg::this_grid();
  __shared__ __attribute__((aligned(16))) char smem[SMEM_BYTES];
  __shared__ uint4 xb_words;
  if (threadIdx.x == 0) xb_words = make_uint4(0u, 0u, 0u, 0u);
  __syncthreads();
  XcdBarrier xb = xcd_barrier_post((unsigned*)(p.ws + OFF_BAR), (volatile LAS unsigned*)&xb_words);
  grid.sync();
  int ph = 0;
#define RUNP(x) { if (ph++ >= STOP_PHASE) return; x; }
  RUNP(phase0(p, smem)); GSYNC(); PROBE_CHECK(); PROBE_CHECK();
  if (DBL_0) { phase0(p, smem); GSYNC(); }
  RUNP(phase0b(p)); GSYNC(); PROBE_CHECK(); PROBE_CHECK();
  for (int l = 0; l < 4; ++l) {
    RUNP(phaseA(p, l, smem)); GSYNC(); PROBE_CHECK(); PROBE_CHECK();
    if (DBL_A) { phaseA(p, l, smem); GSYNC(); }
    RUNP(phaseB(p, l, smem)); GSYNC(); PROBE_CHECK(); PROBE_CHECK();
    if (DBL_B) { phaseB(p, l, smem); GSYNC(); }
    RUNP(phaseD(p, l, smem)); xcd_barrier(xb, (int)blockIdx.x < 128); PROBE_CHECK(); PROBE_CHECK();
    if (DBL_D) { phaseD(p, l, smem); GSYNC(); }
    RUNP(phaseE(p, l, smem)); GSYNC(); PROBE_CHECK(); PROBE_CHECK();
    if (DBL_E) { phaseE(p, l, smem); GSYNC(); }
    RUNP(phaseF(p, l, smem)); GSYNC(); PROBE_CHECK(); PROBE_CHECK();
    RUNP(phaseG(p, l)); GSYNC(); PROBE_CHECK(); PROBE_CHECK();
    if (DBL_G) { phaseG(p, l); GSYNC(); }
    RUNP(phaseH(p, l, smem)); xcd_barrier(xb, (int)blockIdx.x < ((l < 3) ? 64 : 32)); PROBE_CHECK(); PROBE_CHECK();
    if (DBL_H) { phaseH(p, l, smem); GSYNC(); }

    RUNP(phaseI(p, l, smem)); GSYNC(); PROBE_CHECK(); PROBE_CHECK();
    if (DBL_I) { phaseI(p, l, smem); GSYNC(); }
    if (PROBE) { if (blockIdx.x == 0 && threadIdx.x == 0) ((float*)(p.ws + OFF_Y))[0] = (float)((unsigned*)(p.ws + OFF_Y))[8]; GSYNC(); probe_fill(p, 0); return; }
    RUNP(phaseJ(p, l, smem)); GSYNC(); PROBE_CHECK(); PROBE_CHECK();
    if (XSYNC) { for (int q = 0; q < 10; ++q) GSYNC(); }
    RUNP(phaseK(p, l));
    if (l < 3) GSYNC(); PROBE_CHECK();
  }
}
#else
template <int PH>
__global__ void __launch_bounds__(256, 2) phase_kernel(Params p, int l) {
  __shared__ __attribute__((aligned(16))) char smem[SMEM_BYTES];
  if (PH == 0) phase0(p, smem);
  if (PH == 1) phase0b(p);
  if (PH == 2) phaseA(p, l, smem);
  if (PH == 3) phaseB(p, l, smem);
  if (PH == 4) phaseD(p, l, smem);
  if (PH == 5) phaseE(p, l, smem);
  if (PH == 6) phaseF(p, l, smem);
  if (PH == 7) phaseG(p, l);
  if (PH == 8) phaseH(p, l, smem);
  if (PH == 9) phaseI(p, l, smem);
  if (PH == 10) phaseJ(p, l, smem);
  if (PH == 11) phaseK(p, l);
}
#endif

extern "C" void kernel_launch(void* const* d_in, const int* in_sizes, int n_in, void* d_out, int out_size, void* d_ws, size_t ws_size,
                              hipStream_t stream) {
  if (n_in < 27 || ws_size < WS_TOTAL) { fprintf(stderr, "kernel_launch: bad inputs (n_in %d, ws %zu need %zu)\n", n_in, ws_size, (size_t)WS_END); return; }
  Params p{};
  const float** pp = (const float**)&p;
  for (int i = 0; i < 27; ++i) pp[i] = (const float*)d_in[i];
  p.out = (float*)d_out;
  p.ws = (char*)d_ws;
#if !MULTI_LAUNCH
  static int grid_blocks = 0;
  if (!grid_blocks) {
    int dev = 0, cus = 0, per_cu = 0;
    hipGetDevice(&dev);
    hipDeviceGetAttribute(&cus, hipDeviceAttributeMultiprocessorCount, dev);
    hipOccupancyMaxActiveBlocksPerMultiprocessor(&per_cu, mega_kernel, 256, 0);
    if (per_cu < 1) per_cu = 1;
    if (per_cu > 2) per_cu = 2;
    grid_blocks = cus * per_cu;
  }
  (void)hipMemsetAsync((char*)d_ws + OFF_BAR, 0, XCD_BAR_WORDS * sizeof(unsigned) + 256, stream);
  void* args[] = {&p};
  hipError_t e = hipLaunchCooperativeKernel((void*)mega_kernel, dim3(grid_blocks), dim3(256), args, 0, stream);
  if (e != hipSuccess) fprintf(stderr, "cooperative launch failed: %s (grid %d)\n", hipGetErrorString(e), grid_blocks);
#else
  const dim3 g(512), b(256);
  phase_kernel<0><<<g, b, 0, stream>>>(p, 0);
  phase_kernel<1><<<g, b, 0, stream>>>(p, 0);
  for (int l = 0; l < 4; ++l) {
    phase_kernel<2><<<g, b, 0, stream>>>(p, l);
    phase_kernel<3><<<g, b, 0, stream>>>(p, l);
    phase_kernel<4><<<g, b, 0, stream>>>(p, l);
    phase_kernel<5><<<g, b, 0, stream>>>(p, l);
    phase_kernel<6><<<g, b, 0, stream>>>(p, l);
    phase_kernel<7><<<g, b, 0, stream>>>(p, l);
    phase_kernel<8><<<g, b, 0, stream>>>(p, l);
    phase_kernel<9><<<g, b, 0, stream>>>(p, l);
    phase_kernel<10><<<g, b, 0, stream>>>(p, l);
    phase_kernel<11><<<g, b, 0, stream>>>(p, l);
  }
#endif
}
```

```cpp
#include <hip/hip_runtime.h>
#include <hip/hip_cooperative_groups.h>
#include <cstdio>
namespace cg = cooperative_groups;

#ifndef MULTI_LAUNCH
#define MULTI_LAUNCH 0
#endif
#ifndef PROBE
#define PROBE 0
#endif
#define DBL_D 0
#define DBL_I 0
#define DBL_A 0
#define DBL_E 0
#define DBL_B 0
#define DBL_0 0
#define ALLWAVE_WB 1
#define BAR_DELAY 0
#define PROBE_PH 1000
#define PROBE_OFF OFF_EOUT
#define PROBE_WORDS ((size_t)NROWS_E * 512)
#define XSYNC 0
#define DBL_G 0
#define DBL_H 0
#ifndef STOP_PHASE
#define STOP_PHASE 100
#endif

typedef unsigned short bf16_t;
using bf16x8 = __attribute__((ext_vector_type(8))) short;
using f32x4 = __attribute__((ext_vector_type(4))) float;
using u32x4 = __attribute__((ext_vector_type(4))) unsigned;
#define DI __device__ __forceinline__
#define MFMA16(a, b, c) __builtin_amdgcn_mfma_f32_16x16x32_bf16((a), (b), (c), 0, 0, 0)

constexpr int NL = 16384;
constexpr int NC = 512;
constexpr int NT = NL + NC;
constexpr int DM = 1024;
constexpr int INW = 2112;
constexpr int LK = 8448;
constexpr int NROWS_E = 32768 + 512;
constexpr float ALPHA = 1.681792830507429f;
constexpr float LOG2E = 1.4426950408889634f;
constexpr float MLA_QS = 0.10206207261596577f * LOG2E;
constexpr float GQA_QS = 0.125f * LOG2E;
constexpr float GLA_QS = 0.17677669529663687f;
constexpr float LOG2_THETA = 13.287712379549449f;

constexpr int C_GQ = 0, C_GK = 128, C_GV = 256, C_GR = 512, C_GLRF = 768, C_MQA = 800, C_MKVA = 1184, C_MKR = 1440,
              C_AQ = 1472, C_AK = 1856, C_AV = 1984;

constexpr size_t al256(size_t x) { return (x + 255) & ~size_t(255); }
constexpr size_t OFF_MOD = 0;
constexpr size_t OFF_XF = OFF_MOD + al256((size_t)4 * 3 * 6144 * 4);
constexpr size_t OFF_HB = OFF_XF + al256((size_t)NT * DM * 4);
constexpr size_t OFF_CAT = OFF_HB + al256((size_t)NT * DM * 2);
constexpr size_t OFF_Y = OFF_CAT + al256((size_t)NT * DM * 2);
constexpr size_t OFF_PJ = OFF_Y + al256((size_t)NT * DM * 4);
constexpr size_t OFF_QM = OFF_PJ + al256((size_t)NT * INW * 2);
constexpr size_t OFF_KVM = OFF_QM + al256((size_t)NT * 576 * 2);
constexpr size_t OFF_KR = OFF_KVM + al256((size_t)NT * 768 * 2);
constexpr size_t OFF_QG = OFF_KR + al256((size_t)NT * 32 * 2);
constexpr size_t OFF_KG = OFF_QG + al256((size_t)NT * 384 * 2);
constexpr size_t OFF_VTM = OFF_KG + al256((size_t)NT * 128 * 2);
constexpr size_t OFF_VTG = OFF_VTM + al256((size_t)2 * 6 * 64 * LK * 2);
constexpr size_t OFF_U = OFF_VTG + al256((size_t)2 * 2 * 64 * LK * 2);
constexpr size_t OFF_SP = OFF_U + al256((size_t)2112 * 2048 * 4);
constexpr size_t OFF_DEC = OFF_SP + al256((size_t)2112 * 2048 * 4);
constexpr size_t OFF_HID = OFF_DEC + al256((size_t)2112 * 32 * 4);
constexpr size_t OFF_EOUT = OFF_HID + al256((size_t)NROWS_E * DM * 2);
constexpr size_t OFF_AFFT = OFF_EOUT + al256((size_t)NROWS_E * DM * 2);
constexpr size_t OFF_SEL = OFF_AFFT + al256((size_t)16 * NT * 4);
constexpr size_t OFF_ROWTOK = OFF_SEL + al256((size_t)16 * NT * 4);
constexpr size_t OFF_GATEV = OFF_ROWTOK + al256((size_t)NROWS_E * 4);
constexpr size_t OFF_WIN = OFF_GATEV + al256((size_t)NROWS_E * 4);
constexpr size_t OFF_WQB = OFF_WIN + al256((size_t)4 * 2176 * 1024 * 2);
constexpr size_t OFF_WKVB = OFF_WQB + al256((size_t)4 * 640 * 384 * 2);
constexpr size_t OFF_WOUT = OFF_WKVB + al256((size_t)4 * 768 * 256 * 2);
constexpr size_t OFF_WGU = OFF_WOUT + al256((size_t)4 * 1024 * 1024 * 2);
constexpr size_t OFF_WD = OFF_WGU + al256((size_t)64 * 2048 * 1024 * 2);
constexpr size_t WS_END = OFF_WD + al256((size_t)64 * 1024 * 1024 * 2);

constexpr size_t OFF_BAR = WS_END;
constexpr size_t OFF_TAB = WS_END + 16384;
constexpr size_t WS_TOTAL = OFF_TAB + 32768;
constexpr int SMEM_BYTES = 59392;

struct Params {
  const float *x, *c, *ctx, *c_ctx, *w_mod, *b_mod, *w_in, *w_gf, *b_gf, *w_gb, *b_gb, *g_gla, *g_qa, *w_qb, *g_kva, *w_kvb,
      *g_gq, *g_gk, *w_out, *ln1_g, *ln1_b, *w_router, *w_eg, *w_eu, *w_ed, *ln2_g, *ln2_b;
  float* out;
  char* ws;
};

DI int otid() { int t = threadIdx.x; asm volatile("" : "+v"(t)); return t; }
DI int obid() { int t = __builtin_amdgcn_workgroup_id_x(); asm volatile("" : "+s"(t)); return t; }
DI bf16_t f2bf(float f) { unsigned u = __float_as_uint(f); u += 0x7fffu + ((u >> 16) & 1u); return (bf16_t)(u >> 16); }
DI float bf2f(bf16_t b) { return __uint_as_float(((unsigned)b) << 16); }
typedef __bf16 hbf16x2 __attribute__((ext_vector_type(2)));
typedef float f32x2 __attribute__((ext_vector_type(2)));
DI unsigned pack2(float a, float b) { f32x2 v = {a, b}; return __builtin_bit_cast(unsigned, __builtin_convertvector(v, hbf16x2)); }
DI float wave_sum(float v) {
#pragma unroll
  for (int o = 32; o > 0; o >>= 1) v += __shfl_xor(v, o);
  return v;
}
DI float siluf(float x) { return x / (1.f + __expf(-x)); }
DI float logsigf(float z) { return fminf(z, 0.f) - log1pf(__expf(-fabsf(z))); }
DI int tok_set(int tok) { return tok < NL ? (tok >> 13) : 2; }
DI void tok_bp(int tok, int& b, int& pp) {
  if (tok < NL) { b = tok >> 13; pp = 256 + (tok & 8191); }
  else { int t = tok - NL; b = t >> 8; pp = t & 255; }
}

template <class Epi>
DI void gemm_tile(unsigned* g_badcnt, const bf16_t* __restrict__ A, int lda, const int* __restrict__ rowidx, int row0, int nvalid,
                  const bf16_t* __restrict__ Bt, int ldb, int K, bf16_t* smem, Epi epi) {
  const int tid = otid(), lane = tid & 63, wave = tid >> 6;
  const int wm = wave >> 1, wn = wave & 1;
  bf16_t* As = smem;
  bf16_t* Bs = smem + 128 * 72;
  const int lr = tid >> 3, lc = (tid & 7) * 8;
  const bf16_t* ap[4];
  const bf16_t* bp[4];
#pragma unroll
  for (int j = 0; j < 4; ++j) {
    int r = lr + 32 * j;
    int rr = r < nvalid ? r : 0;
    long grow = rowidx ? (long)rowidx[row0 + rr] : (long)(row0 + rr);
    if (rowidx) { if (grow < 0 || grow >= NT) grow = 0; }
    ap[j] = A + grow * lda + lc;
    bp[j] = Bt + (long)r * ldb + lc;
  }
  u32x4 raA[4], rbA[4], raB[4], rbB[4];
  const int nk = K >> 6;
#pragma unroll
  for (int j = 0; j < 4; ++j) { raA[j] = *(const u32x4*)ap[j]; rbA[j] = *(const u32x4*)bp[j]; }
  if (nk > 1) {
#pragma unroll
    for (int j = 0; j < 4; ++j) { raB[j] = *(const u32x4*)(ap[j] + 64); rbB[j] = *(const u32x4*)(bp[j] + 64); }
  }
  f32x4 acc[4][4];
#pragma unroll
  for (int a = 0; a < 4; ++a)
#pragma unroll
    for (int b = 0; b < 4; ++b) acc[a][b] = f32x4{0.f, 0.f, 0.f, 0.f};
  const int l15 = lane & 15, lg = lane >> 4;
  auto stage_and_compute = [&](u32x4 (&ra)[4], u32x4 (&rb)[4], int knext) {
    __syncthreads();
#pragma unroll
    for (int j = 0; j < 4; ++j) {
      *(u32x4*)(As + (lr + 32 * j) * 72 + lc) = ra[j];
      *(u32x4*)(Bs + (lr + 32 * j) * 72 + lc) = rb[j];
    }
    __syncthreads();
    if (knext < nk) {
#pragma unroll
      for (int j = 0; j < 4; ++j) { ra[j] = *(const u32x4*)(ap[j] + knext * 64); rb[j] = *(const u32x4*)(bp[j] + knext * 64); }
    }
    __builtin_amdgcn_sched_barrier(0);
#pragma unroll
    for (int ks = 0; ks < 2; ++ks) {
      bf16x8 af[4], wf[4];
#pragma unroll
      for (int mi = 0; mi < 4; ++mi) af[mi] = *(const bf16x8*)(As + (wm * 64 + mi * 16 + l15) * 72 + ks * 32 + lg * 8);
#pragma unroll
      for (int ni = 0; ni < 4; ++ni) wf[ni] = *(const bf16x8*)(Bs + (wn * 64 + ni * 16 + l15) * 72 + ks * 32 + lg * 8);
#pragma unroll
      for (int ni = 0; ni < 4; ++ni)
#pragma unroll
        for (int mi = 0; mi < 4; ++mi) acc[ni][mi] = MFMA16(wf[ni], af[mi], acc[ni][mi]);
    }
  };
  for (int kt = 0; kt < nk; kt += 2) {
    stage_and_compute(raA, rbA, kt + 2);
    if (kt + 1 >= nk) break;
    stage_and_compute(raB, rbB, kt + 3);
  }
  epi(acc, wm, wn, lane);
}

DI void tile_rowscale(const bf16_t* __restrict__ A, int lda, int row0, int ncols, float* rs) {
  const int tid = otid();
  const int r = tid >> 1, half = tid & 1;
  const int nh = ncols >> 1;
  const bf16_t* src = A + (long)(row0 + r) * lda + half * nh;
  float s = 0.f;
  for (int c = 0; c < nh; c += 8) {
    uint4 v = *(const uint4*)(src + c);
    unsigned w[4] = {v.x, v.y, v.z, v.w};
#pragma unroll
    for (int q = 0; q < 4; ++q) {
      float a = __uint_as_float(w[q] << 16), b = __uint_as_float(w[q] & 0xffff0000u);
      s += a * a + b * b;
    }
  }
  s += __shfl_xor(s, 1);
  if (half == 0) rs[r] = rsqrtf(s / (float)ncols + 1e-6f);
}

struct ConvDesc { const float* src; bf16_t* dst; const float* gs; int K, N, k0, n0, mode; };

DI ConvDesc conv_decode(const Params& p, int i) {
  bf16_t* WIN = (bf16_t*)(p.ws + OFF_WIN);
  bf16_t* WQB = (bf16_t*)(p.ws + OFF_WQB);
  bf16_t* WKVB = (bf16_t*)(p.ws + OFF_WKVB);
  bf16_t* WOUT = (bf16_t*)(p.ws + OFF_WOUT);
  bf16_t* WGU = (bf16_t*)(p.ws + OFF_WGU);
  bf16_t* WD = (bf16_t*)(p.ws + OFF_WD);
  ConvDesc d;
  d.gs = nullptr; d.mode = 0;
  if (i < 2176) { int l = i / 544, r = i % 544; d.src = p.w_in + (size_t)l * 1024 * INW; d.K = 1024; d.N = INW; d.k0 = (r / 34) * 64; d.n0 = (r % 34) * 64; d.dst = WIN + (size_t)l * 2176 * 1024; return d; }
  i -= 2176;
  if (i < 240) { int l = i / 60, r = i % 60; d.src = p.w_qb + (size_t)l * 384 * 576; d.K = 384; d.N = 576; d.k0 = (r / 10) * 64; d.n0 = (r % 10) * 64; d.dst = WQB + (size_t)l * 640 * 384; d.gs = p.g_qa + l * 384; return d; }
  i -= 240;
  if (i < 192) { int l = i / 48, r = i % 48; d.src = p.w_kvb + (size_t)l * 256 * 768; d.K = 256; d.N = 768; d.k0 = (r / 12) * 64; d.n0 = (r % 12) * 64; d.dst = WKVB + (size_t)l * 768 * 256; d.gs = p.g_kva + l * 256; return d; }
  i -= 192;
  if (i < 1024) { int l = i / 256, r = i % 256; d.src = p.w_out + (size_t)l * 1048576; d.K = 1024; d.N = 1024; d.k0 = (r / 16) * 64; d.n0 = (r % 16) * 64; d.dst = WOUT + (size_t)l * 1048576; return d; }
  i -= 1024;
  const int which = i / 16384, ii = i % 16384;
  const int m = ii / 256, r = ii % 256;
  d.K = 1024; d.N = 1024; d.k0 = (r / 16) * 64; d.n0 = (r % 16) * 64;
  if (which == 0) { d.src = p.w_eg + (size_t)m * 1048576; d.dst = WGU + (size_t)m * 2097152; d.mode = 1; }
  else if (which == 1) { d.src = p.w_eu + (size_t)m * 1048576; d.dst = WGU + (size_t)m * 2097152; d.mode = 2; }
  else { d.src = p.w_ed + (size_t)m * 1048576; d.dst = WD + (size_t)m * 1048576; }
  return d;
}

DI void conv_load(const ConvDesc& d, int tid, f32x4 (&v)[4], float (&sc)[4]) {
  const int c4 = (tid & 15) * 4;
#pragma unroll
  for (int j = 0; j < 4; ++j) {
    const int r = (tid >> 4) + 16 * j;
    v[j] = f32x4{0.f, 0.f, 0.f, 0.f};
    if (d.n0 + c4 < d.N) v[j] = *(const f32x4*)(d.src + (size_t)(d.k0 + r) * d.N + d.n0 + c4);
    sc[j] = d.gs ? d.gs[d.k0 + r] : 1.f;
  }
}

DI void conv_store(const ConvDesc& d, int tid, const f32x4 (&v)[4], const float (&sc)[4], float* sm) {
  __syncthreads();
  const int c4 = (tid & 15) * 4;
#pragma unroll
  for (int j = 0; j < 4; ++j) {
    const int r = (tid >> 4) + 16 * j;
    sm[r * 65 + c4 + 0] = v[j][0] * sc[j];
    sm[r * 65 + c4 + 1] = v[j][1] * sc[j];
    sm[r * 65 + c4 + 2] = v[j][2] * sc[j];
    sm[r * 65 + c4 + 3] = v[j][3] * sc[j];
  }
  __syncthreads();
  const int n = tid >> 2, ks = (tid & 3) * 16;
  unsigned w[8];
#pragma unroll
  for (int q = 0; q < 8; ++q) w[q] = pack2(sm[(ks + 2 * q) * 65 + n], sm[(ks + 2 * q + 1) * 65 + n]);
  const int gn = d.n0 + n;
  int drow = gn;
  if (d.mode != 0) drow = (gn >> 5) * 64 + (gn & 31) + (d.mode == 2 ? 32 : 0);
  uint4* dp = (uint4*)(d.dst + (size_t)drow * d.K + d.k0 + ks);
  dp[0] = make_uint4(w[0], w[1], w[2], w[3]);
  dp[1] = make_uint4(w[4], w[5], w[6], w[7]);
}

DI void phase0(const Params& p, char* smem) {
  float* sm = (float*)smem;
  float* MOD = (float*)(p.ws + OFF_MOD);
  const int NCONV = 2176 + 240 + 192 + 1024 + 3 * 16384;
  const int tid = otid();
  const int G = gridDim.x;
  {
    int it = obid();
    f32x4 v[4]; float sc[4];
    ConvDesc cur = conv_decode(p, it < NCONV ? it : 0);
    if (it < NCONV) conv_load(cur, tid, v, sc);
    while (it < NCONV) {
      const int nxt = it + G;
      f32x4 vn[4]; float scn[4];
      ConvDesc dn = conv_decode(p, nxt < NCONV ? nxt : 0);
      if (nxt < NCONV) conv_load(dn, tid, vn, scn);
      conv_store(cur, tid, v, sc, sm);
#pragma unroll
      for (int j = 0; j < 4; ++j) { v[j] = vn[j]; sc[j] = scn[j]; }
      cur = dn;
      it = nxt;
    }
  }
  for (int i = obid(); i < 385; i += G) {
    if (i >= 384) {
      float* TAB = (float*)(p.ws + OFF_TAB);
      for (int q = tid; q < 128 * 24; q += 256) {
        const int pos = q / 24, f = q % 24;
        const float invf = f < 16 ? exp2f(-(float)f * (LOG2_THETA / 16.f)) : exp2f(-(float)(f - 16) * (LOG2_THETA / 8.f));
        const float ang = (float)pos * invf;
        TAB[q * 2] = cosf(ang);
        TAB[q * 2 + 1] = sinf(ang);
      }
      continue;
    }
    {
      const int l = i / 96, n0 = (i % 96) * 64;
      const int lane = tid & 63, wave = tid >> 6;
      __syncthreads();
      for (int k = tid; k < 3072; k += 256) {
        int s = k >> 10, kk = k & 1023;
        float cv = s < 2 ? p.c[s * 1024 + kk] : p.c_ctx[kk];
        sm[k] = cv / (1.f + expf(-cv));
      }
      __syncthreads();
      float a0 = 0.f, a1 = 0.f, a2 = 0.f;
      const float* w = p.w_mod + (size_t)l * 1024 * 6144 + n0 + lane;
#pragma unroll 8
      for (int k = wave * 256; k < wave * 256 + 256; ++k) {
        float wv = w[(size_t)k * 6144];
        a0 += sm[k] * wv; a1 += sm[1024 + k] * wv; a2 += sm[2048 + k] * wv;
      }
      float* part = sm + 3072;
      part[(wave * 3 + 0) * 64 + lane] = a0;
      part[(wave * 3 + 1) * 64 + lane] = a1;
      part[(wave * 3 + 2) * 64 + lane] = a2;
      __syncthreads();
      if (tid < 192) {
        int s = tid >> 6, ln = tid & 63;
        float v2 = part[(0 * 3 + s) * 64 + ln] + part[(1 * 3 + s) * 64 + ln] + part[(2 * 3 + s) * 64 + ln] + part[(3 * 3 + s) * 64 + ln];
        MOD[(size_t)(l * 3 + s) * 6144 + n0 + ln] = v2 + p.b_mod[l * 6144 + n0 + ln];
      }
    }
  }
}

DI void phase0b(const Params& p) {
  float* XF = (float*)(p.ws + OFF_XF);
  bf16_t* HB = (bf16_t*)(p.ws + OFF_HB);
  const float* MOD = (const float*)(p.ws + OFF_MOD);
  const int total = NT * 256;
  for (int idx = obid() * 256 + otid(); idx < total; idx += gridDim.x * 256) {
    int tok = idx >> 8, c = (idx & 255) * 4;
    const float* src = tok < NL ? p.x + (size_t)tok * 1024 : p.ctx + (size_t)(tok - NL) * 1024;
    float4 v = *(const float4*)(src + c);
    *(float4*)(XF + (size_t)tok * 1024 + c) = v;
    const float* md = MOD + (size_t)tok_set(tok) * 6144;
    float4 sh = *(const float4*)(md + c), sc = *(const float4*)(md + 1024 + c);
    uint2 o;
    o.x = pack2(v.x * (1.f + sc.x) + sh.x, v.y * (1.f + sc.y) + sh.y);
    o.y = pack2(v.z * (1.f + sc.z) + sh.z, v.w * (1.f + sc.w) + sh.w);
    *(uint2*)(HB + (size_t)tok * 1024 + c) = o;
  }
}

DI void phaseA(const Params& p, int l, char* smem) {
  const bf16_t* HB = (const bf16_t*)(p.ws + OFF_HB);
  const bf16_t* WIN = (const bf16_t*)(p.ws + OFF_WIN) + (size_t)l * 2176 * 1024;
  bf16_t* PJ = (bf16_t*)(p.ws + OFF_PJ);
  const int ntiles = 132 * 17;
  const int bid_ = obid();
  const bool xmap = (gridDim.x == 512);
  const int xn = xmap ? ((132 - (bid_ & 7) + 7) >> 3) * 17 : 0;
  for (int t_ = xmap ? (bid_ >> 3) : bid_; t_ < (xmap ? xn : ntiles); t_ += (xmap ? 64 : (int)gridDim.x)) {
    const int mt = xmap ? (bid_ & 7) + 8 * (t_ / 17) : t_ / 17, nt = t_ % 17;
    gemm_tile((unsigned*)(p.ws + OFF_Y) + 8, HB, 1024, nullptr, mt * 128, 128, WIN + (size_t)nt * 128 * 1024, 1024, 1024, (bf16_t*)smem,
              [&](f32x4 (&acc)[4][4], int wm, int wn, int lane) {
#pragma unroll
                for (int ni = 0; ni < 4; ++ni) {
                  int n = nt * 128 + wn * 64 + ni * 16 + (lane >> 4) * 4;
                  if (n < INW) {
#pragma unroll
                    for (int mi = 0; mi < 4; ++mi) {
                      int m = mt * 128 + wm * 64 + mi * 16 + (lane & 15);
                      uint2 o;
                      o.x = pack2(acc[ni][mi][0], acc[ni][mi][1]);
                      o.y = pack2(acc[ni][mi][2], acc[ni][mi][3]);
                      *(uint2*)(PJ + (size_t)m * INW + n) = o;
                    }
                  }
                }
              });
  }
}

DI void gla_la8(const bf16_t* __restrict__ PJ, int tok, int dir, const float* __restrict__ W, const float* __restrict__ bias, int h, int d0,
                float* out8) {
  const bf16_t* g = PJ + (size_t)tok * INW + C_GLRF + dir * 16;
  uint4 g0 = *(const uint4*)g, g1 = *(const uint4*)(g + 8);
  unsigned gw[8] = {g0.x, g0.y, g0.z, g0.w, g1.x, g1.y, g1.z, g1.w};
  float a[8];
#pragma unroll
  for (int q = 0; q < 8; ++q) a[q] = bias[h * 32 + d0 + q];
#pragma unroll
  for (int r = 0; r < 16; ++r) {
    float gv = (r & 1) ? __uint_as_float(gw[r >> 1] & 0xffff0000u) : __uint_as_float(gw[r >> 1] << 16);
    const float* wr = W + r * 128 + h * 32 + d0;
#pragma unroll
    for (int q = 0; q < 8; ++q) a[q] += gv * wr[q];
  }
#pragma unroll
  for (int q = 0; q < 8; ++q) out8[q] = logsigf(a[q]) * (1.f / 16.f);
}

DI void gla_cumsum(const bf16_t* __restrict__ PJ, int tok0, int dir, const float* __restrict__ W, const float* __restrict__ bias, int h,
                   float* la, float* blast, float* segtot) {
  const int tid = otid();
  {
    const int t = tid >> 2, d0 = (tid & 3) * 8;
    float o8[8];
    gla_la8(PJ, tok0 + t, dir, W, bias, h, d0, o8);
#pragma unroll
    for (int q = 0; q < 8; ++q) la[t * 32 + d0 + q] = o8[q];
  }
  __syncthreads();
  const int d = tid & 31, seg = tid >> 5;
  float vals[8];
  float run = 0.f;
#pragma unroll
  for (int k = 0; k < 8; ++k) {
    const int o = seg * 8 + k;
    const int t = dir ? 63 - o : o;
    run += la[t * 32 + d];
    vals[k] = run;
  }
  segtot[seg * 32 + d] = run;
  __syncthreads();
  float off = 0.f;
#pragma unroll
  for (int sgi = 0; sgi < 7; ++sgi) off += (sgi < seg) ? segtot[sgi * 32 + d] : 0.f;
#pragma unroll
  for (int k = 0; k < 8; ++k) {
    const int o = seg * 8 + k;
    const int t = dir ? 63 - o : o;
    la[t * 32 + d] = vals[k] + off;
  }
  if (seg == 7) blast[d] = run + off;
  __syncthreads();
}

DI int chunk_tok0(int cidx) { return cidx < 256 ? cidx * 64 : NL + (cidx - 256) * 64; }

DI void gla_u_item(const Params& p, int l, int item, char* smem) {
  const bf16_t* PJ = (const bf16_t*)(p.ws + OFF_PJ);
  float* U = (float*)(p.ws + OFF_U);
  float* DEC = (float*)(p.ws + OFF_DEC);
  const int dir = item & 1, h = (item >> 1) & 3, cidx = item >> 3;
  const int tok0 = chunk_tok0(cidx);
  const float* W = (dir ? p.w_gb : p.w_gf) + l * 16 * 128;
  const float* bias = (dir ? p.b_gb : p.b_gf) + l * 128;
  float* la = (float*)smem;
  float* blast = la + 2048;
  float* segtot = blast + 32;
  bf16_t* VT = (bf16_t*)(segtot + 256);
  bf16_t* KT = VT + 64 * 72;
  const int tid = otid(), lane = tid & 63, wave = tid >> 6;
  const int l15 = lane & 15, lg = lane >> 4;
  __syncthreads();
  gla_cumsum(PJ, tok0, dir, W, bias, h, la, blast, segtot);
  {
    const int t = tid >> 2, d0 = (tid & 3) * 8;
    const bf16_t* kp = PJ + (size_t)(tok0 + t) * INW + C_GK + h * 32 + d0;
    const u32x4 kr = *(const u32x4*)kp;
#pragma unroll
    for (int q = 0; q < 8; ++q) {
      const unsigned wd = kr[q >> 1];
      const float kv = (q & 1) ? __uint_as_float(wd & 0xffff0000u) : __uint_as_float(wd << 16);
      KT[(d0 + q) * 72 + t] = f2bf(kv * __expf(blast[d0 + q] - la[t * 32 + d0 + q]));
    }
    const int e0 = (tid & 3) * 16;
    const bf16_t* vp = PJ + (size_t)(tok0 + t) * INW + C_GV + h * 64 + e0;
    const u32x4 v0 = *(const u32x4*)vp, v1 = *(const u32x4*)(vp + 8);
#pragma unroll
    for (int q = 0; q < 8; ++q) {
      const unsigned w0 = v0[q >> 1], w1 = v1[q >> 1];
      VT[(e0 + q) * 72 + t] = (bf16_t)((q & 1) ? (w0 >> 16) : (w0 & 0xffffu));
      VT[(e0 + 8 + q) * 72 + t] = (bf16_t)((q & 1) ? (w1 >> 16) : (w1 & 0xffffu));
    }
  }
  __syncthreads();
  f32x4 acc[2] = {f32x4{0.f, 0.f, 0.f, 0.f}, f32x4{0.f, 0.f, 0.f, 0.f}};
#pragma unroll
  for (int s2 = 0; s2 < 2; ++s2) {
    const bf16x8 vf = *(const bf16x8*)(VT + (wave * 16 + l15) * 72 + s2 * 32 + lg * 8);
#pragma unroll
    for (int dt = 0; dt < 2; ++dt) {
      const bf16x8 kf = *(const bf16x8*)(KT + (dt * 16 + l15) * 72 + s2 * 32 + lg * 8);
      acc[dt] = MFMA16(vf, kf, acc[dt]);
    }
  }
#pragma unroll
  for (int dt = 0; dt < 2; ++dt) {
    float* up = U + (size_t)item * 2048 + (dt * 16 + l15) * 64 + wave * 16 + lg * 4;
    *(float4*)up = make_float4(acc[dt][0], acc[dt][1], acc[dt][2], acc[dt][3]);
  }
  if (tid < 32) DEC[item * 32 + tid] = __expf(blast[tid]);
}

DI void prep_item(const Params& p, int l, int tile, char* smem) {
  const bf16_t* PJ = (const bf16_t*)(p.ws + OFF_PJ);
  bf16_t* QG = (bf16_t*)(p.ws + OFF_QG);
  bf16_t* KG = (bf16_t*)(p.ws + OFF_KG);
  bf16_t* KR = (bf16_t*)(p.ws + OFF_KR);
  bf16_t* VTG = (bf16_t*)(p.ws + OFF_VTG);
  const float* TAB = (const float*)(p.ws + OFF_TAB);
  const int tok0 = tile * 64;
  const int tid = otid(), lane = tid & 63, wave = tid >> 6;
  const bool lat = tok0 < NL;
  __syncthreads();
  for (int tt = wave; tt < 64; tt += 4) {
    const int tok = tok0 + tt;
    const bf16_t* row = PJ + (size_t)tok * INW;
    float v[8];
#pragma unroll
    for (int hh = 0; hh < 8; ++hh) v[hh] = bf2f(row[(hh < 6 ? C_AQ + hh * 64 : C_AK + (hh - 6) * 64) + lane]);
    float kr = bf2f(row[C_MKR + (lane & 31)]);
    const int t = tok & 8191;
    float csg = 1.f, sng = 0.f, csm = 1.f, snm = 0.f;
    if (lat) {
      const float2 a = *(const float2*)(TAB + ((lane < 32 ? (t >> 6) : (t & 63)) * 24 + (lane & 15)) * 2);
      csg = a.x; sng = a.y;
      const int r = lane & 31;
      const float2 m2 = *(const float2*)(TAB + (((r >> 4) ? (t & 63) : (t >> 6)) * 24 + 16 + (r & 7)) * 2);
      csm = m2.x; snm = m2.y;
    }
    const float gq = p.g_gq[l * 64 + lane], gk = p.g_gk[l * 64 + lane];
#pragma unroll
    for (int hh = 0; hh < 8; ++hh) {
      const float ss = wave_sum(v[hh] * v[hh]);
      const float rn = rsqrtf(ss * (1.f / 64.f) + 1e-6f);
      float y = v[hh] * rn * (hh < 6 ? gq : gk);
      const float partner = __shfl_xor(y, 16);
      y = ((lane >> 4) & 1) ? (partner * sng + y * csg) : (y * csg - partner * sng);
      if (hh < 6) QG[(size_t)tok * 384 + hh * 64 + lane] = f2bf(y * GQA_QS);
      else KG[(size_t)tok * 128 + (hh - 6) * 64 + lane] = f2bf(y);
    }
    {
      const float partner = __shfl_xor(kr, 8);
      const int r = lane & 31;
      kr = ((r >> 3) & 1) ? (partner * snm + kr * csm) : (kr * csm - partner * snm);
      if (lane < 32) KR[(size_t)tok * 32 + r] = f2bf(kr);
    }
  }
  bf16_t* sm = (bf16_t*)smem;
  for (int c = tid; c < 64 * 16; c += 256) {
    int t = c >> 4, cc = (c & 15) * 8;
    *(uint4*)(sm + t * 136 + cc) = *(const uint4*)(PJ + (size_t)(tok0 + t) * INW + C_AV + cc);
  }
  __syncthreads();
  {
    int b, pp;
    tok_bp(tok0, b, pp);
    const int c = tid >> 1, half = tid & 1;
    const int kvh = c >> 6, dv = c & 63;
    unsigned w[16];
#pragma unroll
    for (int q = 0; q < 16; ++q) {
      unsigned lo = sm[(half * 32 + 2 * q) * 136 + c], hi = sm[(half * 32 + 2 * q + 1) * 136 + c];
      w[q] = lo | (hi << 16);
    }
    uint4* d = (uint4*)(VTG + ((size_t)((b * 2 + kvh) * 64 + dv)) * LK + pp + half * 32);
    d[0] = make_uint4(w[0], w[1], w[2], w[3]);
    d[1] = make_uint4(w[4], w[5], w[6], w[7]);
    d[2] = make_uint4(w[8], w[9], w[10], w[11]);
    d[3] = make_uint4(w[12], w[13], w[14], w[15]);
  }
}

DI void phaseB(const Params& p, int l, char* smem) {
  const bf16_t* PJ = (const bf16_t*)(p.ws + OFF_PJ);
  const bf16_t* WQB = (const bf16_t*)(p.ws + OFF_WQB) + (size_t)l * 640 * 384;
  const bf16_t* WKVB = (const bf16_t*)(p.ws + OFF_WKVB) + (size_t)l * 768 * 256;
  bf16_t* QM = (bf16_t*)(p.ws + OFF_QM);
  bf16_t* KVM = (bf16_t*)(p.ws + OFF_KVM);
  bf16_t* VTM = (bf16_t*)(p.ws + OFF_VTM);
  float* rs = (float*)(smem + 2 * 128 * 72 * 2);
  const float* TAB = (const float*)(p.ws + OFF_TAB);
  const int N_G2 = 132 * 5, N_G3 = 132 * 6, N_PREP = 264, N_U = 2112;
  const int total = N_G2 + N_G3 + N_PREP + N_U;
  for (int it = obid(); it < total; it += gridDim.x) {
    int id = it;
    if (id < N_G2) {
      const int mt = id / 5, nt = id % 5;
      __syncthreads();
      tile_rowscale(PJ + C_MQA, INW, mt * 128, 384, rs);
      gemm_tile((unsigned*)(p.ws + OFF_Y) + 8, PJ + C_MQA, INW, nullptr, mt * 128, 128, WQB + (size_t)nt * 128 * 384, 384, 384, (bf16_t*)smem,
                [&](f32x4 (&acc)[4][4], int wm, int wn, int lane) {
#pragma unroll
                  for (int ni = 0; ni < 4; ++ni) {
                    const int n = nt * 128 + wn * 64 + ni * 16 + (lane >> 4) * 4;
                    const int d = n % 96;
#pragma unroll
                    for (int mi = 0; mi < 4; ++mi) {
                      const int ml = wm * 64 + mi * 16 + (lane & 15);
                      const int tok = mt * 128 + ml;
                      const float rsc = rs[ml];
                      float v[4], pr[4];
#pragma unroll
                      for (int i = 0; i < 4; ++i) { v[i] = acc[ni][mi][i] * rsc; pr[i] = __shfl_xor(v[i], 32); }
                      if (d >= 64 && tok < NL && n < 576) {
                        const int r = d - 64;
                        const int t = tok & 8191;
                        const int pos = (r >> 4) ? (t & 63) : (t >> 6);
                        const bool second = (r >> 3) & 1;
                        const float* tb = TAB + (pos * 24 + 16 + (r & 7)) * 2;
                        const float4 c01 = *(const float4*)tb, c23 = *(const float4*)(tb + 4);
                        const float csv[4] = {c01.x, c01.z, c23.x, c23.z}, snv[4] = {c01.y, c01.w, c23.y, c23.w};
#pragma unroll
                        for (int i = 0; i < 4; ++i) v[i] = second ? (pr[i] * snv[i] + v[i] * csv[i]) : (v[i] * csv[i] - pr[i] * snv[i]);
                      }
                      if (n < 576) {
                        uint2 o;
                        o.x = pack2(v[0] * MLA_QS, v[1] * MLA_QS);
                        o.y = pack2(v[2] * MLA_QS, v[3] * MLA_QS);
                        *(uint2*)(QM + (size_t)tok * 576 + n) = o;
                      }
                    }
                  }
                });
      continue;
    }
    id -= N_G2;
    if (id < N_G3) {
      const int mt = id / 6, nt = id % 6;
      __syncthreads();
      tile_rowscale(PJ + C_MKVA, INW, mt * 128, 256, rs);
      gemm_tile((unsigned*)(p.ws + OFF_Y) + 8, PJ + C_MKVA, INW, nullptr, mt * 128, 128, WKVB + (size_t)nt * 128 * 256, 256, 256, (bf16_t*)smem,
                [&](f32x4 (&acc)[4][4], int wm, int wn, int lane) {
#pragma unroll
                  for (int ni = 0; ni < 4; ++ni) {
                    const int cl = ni * 16 + (lane >> 4) * 4;
#pragma unroll
                    for (int mi = 0; mi < 4; ++mi) {
                      const int ml = wm * 64 + mi * 16 + (lane & 15);
                      const int tok = mt * 128 + ml;
                      const float rsc = rs[ml];
                      float v[4];
#pragma unroll
                      for (int i = 0; i < 4; ++i) v[i] = acc[ni][mi][i] * rsc;
                      if (wn == 0) {
                        uint2 o;
                        o.x = pack2(v[0], v[1]);
                        o.y = pack2(v[2], v[3]);
                        *(uint2*)(KVM + (size_t)tok * 768 + nt * 128 + cl) = o;
                      } else {
                        int b, pp;
                        tok_bp(tok, b, pp);
                        bf16_t* vt = VTM + ((size_t)((b * 6 + nt) * 64 + cl)) * LK + pp;
#pragma unroll
                        for (int i = 0; i < 4; ++i) vt[(size_t)i * LK] = f2bf(v[i]);
                      }
                    }
                  }
                });
      continue;
    }
    id -= N_G3;
    if (id < N_PREP) { prep_item(p, l, id, smem); continue; }
    id -= N_PREP;
    gla_u_item(p, l, id, smem);
  }
}

template <bool MLA>
DI void attn_item(const bf16_t* __restrict__ Qb, int ldq, const bf16_t* __restrict__ Kb, int ldk, const bf16_t* __restrict__ KRb,
                  const bf16_t* __restrict__ Vt, int b, int qtok0, int ntiles, bool ctxq, bf16_t* __restrict__ outp, bf16_t* smem) {
  constexpr int DQK = MLA ? 96 : 64;
  constexpr int KST = DQK + 8;
  constexpr int CPR = DQK / 8;
  constexpr int NKC = 64 * CPR / 256;
  constexpr int NKS = DQK / 32;
  constexpr int BUF = 64 * KST + 64 * 72;
  const int tid = otid(), lane = tid & 63, wave = tid >> 6;
  const int l15 = lane & 15, lg = lane >> 4;
  bf16x8 qf[2][NKS];
#pragma unroll
  for (int mi = 0; mi < 2; ++mi)
#pragma unroll
    for (int ks = 0; ks < NKS; ++ks)
      qf[mi][ks] = *(const bf16x8*)(Qb + (size_t)(qtok0 + wave * 32 + mi * 16 + l15) * ldq + ks * 32 + lg * 8);
  int krow[NKC], kcc[NKC];
#pragma unroll
  for (int j = 0; j < NKC; ++j) { int c = tid + 256 * j; krow[j] = c / CPR; kcc[j] = c % CPR; }
  u32x4 rk[NKC], rv[2];
  auto load_tile = [&](int kt) {
    int ktok0;
    if (ctxq || kt < 4) ktok0 = NL + b * 256 + kt * 64; else ktok0 = b * 8192 + (kt - 4) * 64;
#pragma unroll
    for (int j = 0; j < NKC; ++j) {
      const bf16_t* src;
      if (MLA && kcc[j] >= 8) src = KRb + (size_t)(ktok0 + krow[j]) * 32 + (kcc[j] - 8) * 8;
      else src = Kb + (size_t)(ktok0 + krow[j]) * ldk + kcc[j] * 8;
      rk[j] = *(const u32x4*)src;
    }
#pragma unroll
    for (int j = 0; j < 2; ++j) {
      int c = tid + 256 * j;
      rv[j] = *(const u32x4*)(Vt + (size_t)(c >> 3) * LK + kt * 64 + (c & 7) * 8);
    }
  };
  auto store_tile = [&](int buf) {
    bf16_t* Ks = smem + buf * BUF;
    bf16_t* Vs = Ks + 64 * KST;
#pragma unroll
    for (int j = 0; j < NKC; ++j) *(u32x4*)(Ks + krow[j] * KST + kcc[j] * 8) = rk[j];
#pragma unroll
    for (int j = 0; j < 2; ++j) { int c = tid + 256 * j; *(u32x4*)(Vs + (c >> 3) * 72 + (c & 7) * 8) = rv[j]; }
  };
  f32x4 o[4][2];
#pragma unroll
  for (int a = 0; a < 4; ++a)
#pragma unroll
    for (int c = 0; c < 2; ++c) o[a][c] = f32x4{0.f, 0.f, 0.f, 0.f};
  float mrun[2] = {-1e30f, -1e30f}, lrun[2] = {0.f, 0.f};
  __syncthreads();
  load_tile(0);
  store_tile(0);
  if (ntiles > 1) load_tile(1);
  __syncthreads();
  for (int kt = 0; kt < ntiles; ++kt) {
    if (kt + 1 < ntiles) {
      store_tile((kt + 1) & 1);
      if (kt + 2 < ntiles) load_tile(kt + 2);
    }
    const bf16_t* Ks = smem + (kt & 1) * BUF;
    const bf16_t* Vs = Ks + 64 * KST;
    f32x4 s[2][4];
#pragma unroll
    for (int mi = 0; mi < 2; ++mi)
#pragma unroll
      for (int ni = 0; ni < 4; ++ni) s[mi][ni] = f32x4{0.f, 0.f, 0.f, 0.f};
#pragma unroll
    for (int ks = 0; ks < NKS; ++ks) {
#pragma unroll
      for (int ni = 0; ni < 4; ++ni) {
        bf16x8 kf = *(const bf16x8*)(Ks + (ni * 16 + l15) * KST + ks * 32 + lg * 8);
#pragma unroll
        for (int mi = 0; mi < 2; ++mi) s[mi][ni] = MFMA16(kf, qf[mi][ks], s[mi][ni]);
      }
    }
    float pmx[2];
    bool need = false;
#pragma unroll
    for (int mi = 0; mi < 2; ++mi) {
      float mx = fmaxf(fmaxf(s[mi][0][0], s[mi][0][1]), fmaxf(s[mi][0][2], s[mi][0][3]));
#pragma unroll
      for (int ni = 1; ni < 4; ++ni) mx = fmaxf(mx, fmaxf(fmaxf(s[mi][ni][0], s[mi][ni][1]), fmaxf(s[mi][ni][2], s[mi][ni][3])));
      pmx[mi] = mx;
      need = need || (mx > mrun[mi] + 8.f);
    }
    if (__any(need)) {
#pragma unroll
      for (int mi = 0; mi < 2; ++mi) {
        float mx = pmx[mi];
        mx = fmaxf(mx, __shfl_xor(mx, 16));
        mx = fmaxf(mx, __shfl_xor(mx, 32));
        const float mnew = fmaxf(mrun[mi], mx);
        const float alpha = __builtin_amdgcn_exp2f(mrun[mi] - mnew);
        mrun[mi] = mnew;
        lrun[mi] *= alpha;
#pragma unroll
        for (int nd = 0; nd < 4; ++nd)
#pragma unroll
          for (int i = 0; i < 4; ++i) o[nd][mi][i] *= alpha;
      }
    }
    bf16x8 pf[2][2];
#pragma unroll
    for (int mi = 0; mi < 2; ++mi) {
      const float mref = mrun[mi];
      f32x2 rs2 = {0.f, 0.f};
#pragma unroll
      for (int ni = 0; ni < 4; ++ni) {
        f32x2 p01 = {__builtin_amdgcn_exp2f(s[mi][ni][0] - mref), __builtin_amdgcn_exp2f(s[mi][ni][1] - mref)};
        f32x2 p23 = {__builtin_amdgcn_exp2f(s[mi][ni][2] - mref), __builtin_amdgcn_exp2f(s[mi][ni][3] - mref)};
        rs2 += p01;
        rs2 += p23;
        s[mi][ni][0] = p01[0]; s[mi][ni][1] = p01[1]; s[mi][ni][2] = p23[0]; s[mi][ni][3] = p23[1];
      }
      lrun[mi] += rs2[0] + rs2[1];
#pragma unroll
      for (int s2 = 0; s2 < 2; ++s2) {
        u32x4 u = {pack2(s[mi][2 * s2][0], s[mi][2 * s2][1]), pack2(s[mi][2 * s2][2], s[mi][2 * s2][3]),
                   pack2(s[mi][2 * s2 + 1][0], s[mi][2 * s2 + 1][1]), pack2(s[mi][2 * s2 + 1][2], s[mi][2 * s2 + 1][3])};
        pf[mi][s2] = __builtin_bit_cast(bf16x8, u);
      }
    }
#pragma unroll
    for (int s2 = 0; s2 < 2; ++s2) {
#pragma unroll
      for (int nd = 0; nd < 4; ++nd) {
        const bf16_t* vb = Vs + (nd * 16 + l15) * 72 + 32 * s2 + 4 * lg;
        uint2 lo = *(const uint2*)vb, hi = *(const uint2*)(vb + 16);
        u32x4 u = {lo.x, lo.y, hi.x, hi.y};
        bf16x8 vf = __builtin_bit_cast(bf16x8, u);
#pragma unroll
        for (int mi = 0; mi < 2; ++mi) o[nd][mi] = MFMA16(vf, pf[mi][s2], o[nd][mi]);
      }
    }
    __syncthreads();
  }
#pragma unroll
  for (int mi = 0; mi < 2; ++mi) {
    float lt = lrun[mi];
    lt += __shfl_xor(lt, 16);
    lt += __shfl_xor(lt, 32);
    const float inv = 1.f / lt;
    const int q = qtok0 + wave * 32 + mi * 16 + l15;
#pragma unroll
    for (int nd = 0; nd < 4; ++nd) {
      uint2 w;
      w.x = pack2(o[nd][mi][0] * inv, o[nd][mi][1] * inv);
      w.y = pack2(o[nd][mi][2] * inv, o[nd][mi][3] * inv);
      *(uint2*)(outp + (size_t)q * 1024 + nd * 16 + lg * 4) = w;
    }
  }
}

DI void attn_dispatch(const Params& p, int combo, int qt, bool ctxq, char* smem) {
  const bf16_t* QM = (const bf16_t*)(p.ws + OFF_QM);
  const bf16_t* KVM = (const bf16_t*)(p.ws + OFF_KVM);
  const bf16_t* KR = (const bf16_t*)(p.ws + OFF_KR);
  const bf16_t* QG = (const bf16_t*)(p.ws + OFF_QG);
  const bf16_t* KG = (const bf16_t*)(p.ws + OFF_KG);
  const bf16_t* VTM = (const bf16_t*)(p.ws + OFF_VTM);
  const bf16_t* VTG = (const bf16_t*)(p.ws + OFF_VTG);
  bf16_t* CAT = (bf16_t*)(p.ws + OFF_CAT);
  const bool mla = combo < 12;
  const int c2 = mla ? combo : combo - 12;
  const int b = c2 / 6, h = c2 % 6;
  const int qtok0 = ctxq ? NL + b * 256 + qt * 128 : b * 8192 + qt * 128;
  const int ntiles = ctxq ? 4 : 132;
  if (mla)
    attn_item<true>(QM + h * 96, 576, KVM + h * 128, 768, KR, VTM + (size_t)((b * 6 + h) * 64) * LK, b, qtok0, ntiles, ctxq,
                    CAT + 256 + h * 64, (bf16_t*)smem);
  else {
    const int kvh = h / 3;
    attn_item<false>(QG + h * 64, 384, KG + kvh * 64, 128, nullptr, VTG + (size_t)((b * 2 + kvh) * 64) * LK, b, qtok0, ntiles, ctxq,
                     CAT + 640 + h * 64, (bf16_t*)smem);
  }
}

DI void scan_item(const Params& p, int item) {
  const float* __restrict__ U = (const float*)(p.ws + OFF_U);
  const float* __restrict__ DEC = (const float*)(p.ws + OFF_DEC);
  float* __restrict__ SP = (float*)(p.ws + OFF_SP);
  const int eb = item & 7, dir = (item >> 3) & 1, h = (item >> 4) & 3, b = item >> 6;
  const int idx = eb * 256 + otid();
  const int d = idx >> 6;
  float s = 0.f;
#pragma unroll 4
  for (int step = 0; step < 132; ++step) {
    int cidx;
    if (step < 4) cidx = 256 + b * 4 + (dir ? 3 - step : step);
    else { int n = step - 4; cidx = b * 128 + (dir ? 127 - n : n); }
    const int it = (cidx * 4 + h) * 2 + dir;
    const float u = U[(size_t)it * 2048 + idx];
    const float dc = DEC[it * 32 + d];
    SP[(size_t)it * 2048 + idx] = s;
    s = dc * s + u;
  }
}

DI void phaseD(const Params& p, int l, char* smem) {
  const int n_ctx = (l < 3) ? 48 : 0;
  const int bid = obid(), G = gridDim.x;
  for (int it = bid; it < 128; it += G) scan_item(p, it);
  if (G == 512) {
    for (int r = 0; r < 3; ++r) attn_dispatch(p, r * 8 + (bid & 7), bid >> 3, false, smem);
  } else {
    for (int it = bid; it < 1536; it += G) attn_dispatch(p, it >> 6, it & 63, false, smem);
  }
  for (int it = (bid + 200) % G; it < n_ctx; it += G) attn_dispatch(p, it >> 1, it & 1, true, smem);
}

DI void gla_out_item(const Params& p, int l, int item, char* smem) {
  const bf16_t* PJ = (const bf16_t*)(p.ws + OFF_PJ);
  const float* SP = (const float*)(p.ws + OFF_SP);
  bf16_t* CAT = (bf16_t*)(p.ws + OFF_CAT);
  const int h = item & 3, cidx = item >> 2;
  const int tok0 = chunk_tok0(cidx);
  float* la = (float*)smem;
  float* blast = la + 2048;
  float* segtot = blast + 32;
  bf16_t* VT = (bf16_t*)(segtot + 256);
  bf16_t* QD = VT + 64 * 72;
  bf16_t* KI = QD + 64 * 40;
  bf16_t* ST = KI + 64 * 40;
  const int tid = otid(), lane = tid & 63, wave = tid >> 6;
  const int l15 = lane & 15, lg = lane >> 4;
  const int t = tid >> 2;
  __syncthreads();
  {
    const int e0 = (tid & 3) * 16;
    const bf16_t* vp = PJ + (size_t)(tok0 + t) * INW + C_GV + h * 64 + e0;
    const u32x4 v0 = *(const u32x4*)vp, v1 = *(const u32x4*)(vp + 8);
#pragma unroll
    for (int q = 0; q < 8; ++q) {
      const unsigned w0 = v0[q >> 1], w1 = v1[q >> 1];
      VT[(e0 + q) * 72 + t] = (bf16_t)((q & 1) ? (w0 >> 16) : (w0 & 0xffffu));
      VT[(e0 + 8 + q) * 72 + t] = (bf16_t)((q & 1) ? (w1 >> 16) : (w1 & 0xffffu));
    }
  }
  f32x4 o[4];
#pragma unroll
  for (int et = 0; et < 4; ++et) o[et] = f32x4{0.f, 0.f, 0.f, 0.f};
#pragma unroll 1
  for (int dir = 0; dir < 2; ++dir) {
    const float* W = (dir ? p.w_gb : p.w_gf) + l * 16 * 128;
    const float* bias = (dir ? p.b_gb : p.b_gf) + l * 128;
    __syncthreads();
    gla_cumsum(PJ, tok0, dir, W, bias, h, la, blast, segtot);
    {
      const int d0 = (tid & 3) * 8;
      const u32x4 qr = *(const u32x4*)(PJ + (size_t)(tok0 + t) * INW + C_GQ + h * 32 + d0);
      const u32x4 kr = *(const u32x4*)(PJ + (size_t)(tok0 + t) * INW + C_GK + h * 32 + d0);
      u32x4 qo, ko;
#pragma unroll
      for (int q2 = 0; q2 < 4; ++q2) {
        const float b0 = la[t * 32 + d0 + 2 * q2], b1 = la[t * 32 + d0 + 2 * q2 + 1];
        const float q0 = __uint_as_float(qr[q2] << 16), q1 = __uint_as_float(qr[q2] & 0xffff0000u);
        const float k0 = __uint_as_float(kr[q2] << 16), k1 = __uint_as_float(kr[q2] & 0xffff0000u);
        qo[q2] = pack2(q0 * GLA_QS * __expf(b0), q1 * GLA_QS * __expf(b1));
        ko[q2] = pack2(k0 * __expf(-b0), k1 * __expf(-b1));
      }
      *(u32x4*)(QD + t * 40 + d0) = qo;
      *(u32x4*)(KI + t * 40 + d0) = ko;
      const int it = (cidx * 4 + h) * 2 + dir;
      const int sd = tid >> 3, se0 = (tid & 7) * 8;
      const float* sp = SP + (size_t)it * 2048 + sd * 64 + se0;
      const float4 s0 = *(const float4*)sp, s1 = *(const float4*)(sp + 4);
      const float sv[8] = {s0.x, s0.y, s0.z, s0.w, s1.x, s1.y, s1.z, s1.w};
#pragma unroll
      for (int q = 0; q < 8; ++q) ST[(se0 + q) * 40 + sd] = f2bf(sv[q]);
    }
    __syncthreads();
    const bf16x8 qf = *(const bf16x8*)(QD + (wave * 16 + l15) * 40 + lg * 8);
    f32x4 at[4];
#pragma unroll
    for (int jt = 0; jt < 4; ++jt) {
      const bf16x8 kf = *(const bf16x8*)(KI + (jt * 16 + l15) * 40 + lg * 8);
      at[jt] = MFMA16(kf, qf, (f32x4{0.f, 0.f, 0.f, 0.f}));
      const int i = wave * 16 + l15;
#pragma unroll
      for (int r = 0; r < 4; ++r) {
        const int j = jt * 16 + lg * 4 + r;
        const bool keep = dir ? (j >= i) : (j <= i);
        at[jt][r] = keep ? at[jt][r] : 0.f;
      }
    }
#pragma unroll
    for (int s2 = 0; s2 < 2; ++s2) {
      u32x4 u = {pack2(at[2 * s2][0], at[2 * s2][1]), pack2(at[2 * s2][2], at[2 * s2][3]),
                 pack2(at[2 * s2 + 1][0], at[2 * s2 + 1][1]), pack2(at[2 * s2 + 1][2], at[2 * s2 + 1][3])};
      const bf16x8 pf = __builtin_bit_cast(bf16x8, u);
#pragma unroll
      for (int et = 0; et < 4; ++et) {
        const bf16_t* vb = VT + (et * 16 + l15) * 72 + 32 * s2 + 4 * lg;
        const uint2 lo = *(const uint2*)vb, hi = *(const uint2*)(vb + 16);
        u32x4 vu = {lo.x, lo.y, hi.x, hi.y};
        o[et] = MFMA16(__builtin_bit_cast(bf16x8, vu), pf, o[et]);
      }
    }
#pragma unroll
    for (int et = 0; et < 4; ++et) {
      const bf16x8 sf = *(const bf16x8*)(ST + (et * 16 + l15) * 40 + lg * 8);
      o[et] = MFMA16(sf, qf, o[et]);
    }
  }
  float ss = 0.f;
#pragma unroll
  for (int et = 0; et < 4; ++et)
#pragma unroll
    for (int r = 0; r < 4; ++r) ss += o[et][r] * o[et][r];
  ss += __shfl_xor(ss, 16);
  ss += __shfl_xor(ss, 32);
  const float rn = rsqrtf(ss * (1.f / 64.f) + 1e-6f);
  const int tok = tok0 + wave * 16 + l15;
#pragma unroll
  for (int et = 0; et < 4; ++et) {
    const int e = et * 16 + lg * 4;
    const uint2 rr = *(const uint2*)(PJ + (size_t)tok * INW + C_GR + h * 64 + e);
    const float4 gg = *(const float4*)(p.g_gla + l * 64 + e);
    const float r0 = __uint_as_float(rr.x << 16), r1 = __uint_as_float(rr.x & 0xffff0000u);
    const float r2 = __uint_as_float(rr.y << 16), r3 = __uint_as_float(rr.y & 0xffff0000u);
    uint2 w;
    w.x = pack2(o[et][0] * rn * gg.x * siluf(r0), o[et][1] * rn * gg.y * siluf(r1));
    w.y = pack2(o[et][2] * rn * gg.z * siluf(r2), o[et][3] * rn * gg.w * siluf(r3));
    *(uint2*)(CAT + (size_t)tok * 1024 + h * 64 + e) = w;
  }
}

DI void phaseE(const Params& p, int l, char* smem) {
  const int n = (l < 3 ? 264 : 256) * 4;
  for (int it = obid(); it < n; it += gridDim.x) gla_out_item(p, l, it, smem);
}

DI void phaseF(const Params& p, int l, char* smem) {
  const bf16_t* CAT = (const bf16_t*)(p.ws + OFF_CAT);
  const bf16_t* WOUT = (const bf16_t*)(p.ws + OFF_WOUT) + (size_t)l * 1048576;
  const float* XF = (const float*)(p.ws + OFF_XF);
  const float* MOD = (const float*)(p.ws + OFF_MOD) + (size_t)l * 3 * 6144;
  float* Y = (float*)(p.ws + OFF_Y);
  const int nmt = (l < 3 ? 132 : 128);
  const int ntiles = nmt * 8;
  const int bid_ = obid();
  const bool xmap = (gridDim.x == 512);
  const int xn = xmap ? ((nmt - (bid_ & 7) + 7) >> 3) * 8 : 0;
  for (int t_ = xmap ? (bid_ >> 3) : bid_; t_ < (xmap ? xn : ntiles); t_ += (xmap ? 64 : (int)gridDim.x)) {
    const int mt = xmap ? (bid_ & 7) + 8 * (t_ >> 3) : (t_ >> 3), nt = t_ & 7;
    gemm_tile((unsigned*)(p.ws + OFF_Y) + 8, CAT, 1024, nullptr, mt * 128, 128, WOUT + (size_t)nt * 128 * 1024, 1024, 1024, (bf16_t*)smem,
              [&](f32x4 (&acc)[4][4], int wm, int wn, int lane) {
                const float* g1 = MOD + (size_t)tok_set(mt * 128) * 6144 + 2048;
#pragma unroll
                for (int ni = 0; ni < 4; ++ni) {
                  const int n = nt * 128 + wn * 64 + ni * 16 + (lane >> 4) * 4;
                  const float4 g = *(const float4*)(g1 + n);
#pragma unroll
                  for (int mi = 0; mi < 4; ++mi) {
                    const int m = mt * 128 + wm * 64 + mi * 16 + (lane & 15);
                    const float4 xv = *(const float4*)(XF + (size_t)m * 1024 + n);
                    float4 r;
                    r.x = ALPHA * xv.x + g.x * acc[ni][mi][0];
                    r.y = ALPHA * xv.y + g.y * acc[ni][mi][1];
                    r.z = ALPHA * xv.z + g.z * acc[ni][mi][2];
                    r.w = ALPHA * xv.w + g.w * acc[ni][mi][3];
                    *(float4*)(Y + (size_t)m * 1024 + n) = r;
                  }
                }
              });
  }
}

DI void phaseG(const Params& p, int l) {
  const int ntok = (l < 3) ? NT : NL;
  const int tid_ = otid(); const int lane = tid_ & 63, wave = tid_ >> 6;
  const float* Y = (const float*)(p.ws + OFF_Y);
  float* XF = (float*)(p.ws + OFF_XF);
  bf16_t* HB = (bf16_t*)(p.ws + OFF_HB);
  float* AFFT = (float*)(p.ws + OFF_AFFT);
  const float* MODl = (const float*)(p.ws + OFF_MOD) + (size_t)l * 3 * 6144;
  const float* g = p.ln1_g + l * 1024;
  const float* bb = p.ln1_b + l * 1024;
  const float* wr = p.w_router + (size_t)l * 1024 * 16;
  const int ngroups = ntok >> 1;
  for (int tg = obid() * 4 + wave; tg < ngroups; tg += gridDim.x * 4) {
    const int tok0 = tg * 2;
    const float* md = MODl + (size_t)tok_set(tok0) * 6144;
    float v[2][16];
#pragma unroll
    for (int t = 0; t < 2; ++t)
#pragma unroll
      for (int j = 0; j < 4; ++j) {
        float4 t4 = *(const float4*)(Y + (size_t)(tok0 + t) * 1024 + j * 256 + lane * 4);
        v[t][4 * j] = t4.x; v[t][4 * j + 1] = t4.y; v[t][4 * j + 2] = t4.z; v[t][4 * j + 3] = t4.w;
      }
    float mean[2], rstd[2];
#pragma unroll
    for (int t = 0; t < 2; ++t) {
      float s = 0.f;
#pragma unroll
      for (int q = 0; q < 16; ++q) s += v[t][q];
      mean[t] = wave_sum(s) * (1.f / 1024.f);
      float qq = 0.f;
#pragma unroll
      for (int q = 0; q < 16; ++q) { float dlt = v[t][q] - mean[t]; qq += dlt * dlt; }
      rstd[t] = rsqrtf(wave_sum(qq) * (1.f / 1024.f) + 1e-6f);
    }
    float lg[32];
#pragma unroll
    for (int q = 0; q < 32; ++q) lg[q] = 0.f;
#pragma unroll
    for (int j = 0; j < 4; ++j) {
      const int col = j * 256 + lane * 4;
      const float4 g4 = *(const float4*)(g + col), b4 = *(const float4*)(bb + col);
      const float4 sh = *(const float4*)(md + 3072 + col), sc = *(const float4*)(md + 4096 + col);
      const float gg[4] = {g4.x, g4.y, g4.z, g4.w}, bv[4] = {b4.x, b4.y, b4.z, b4.w};
      const float shv[4] = {sh.x, sh.y, sh.z, sh.w}, scv[4] = {sc.x, sc.y, sc.z, sc.w};
      float hh[2][4];
#pragma unroll
      for (int t = 0; t < 2; ++t) {
        float xn[4];
#pragma unroll
        for (int c = 0; c < 4; ++c) {
          xn[c] = (v[t][4 * j + c] - mean[t]) * rstd[t] * gg[c] + bv[c];
          hh[t][c] = xn[c] * (1.f + scv[c]) + shv[c];
        }
        *(float4*)(XF + (size_t)(tok0 + t) * 1024 + col) = make_float4(xn[0], xn[1], xn[2], xn[3]);
        uint2 o;
        o.x = pack2(hh[t][0], hh[t][1]);
        o.y = pack2(hh[t][2], hh[t][3]);
        *(uint2*)(HB + (size_t)(tok0 + t) * 1024 + col) = o;
      }
#pragma unroll
      for (int c = 0; c < 4; ++c) {
        const float4* wrow = (const float4*)(wr + (size_t)(col + c) * 16);
        const float4 w0 = wrow[0], w1 = wrow[1], w2 = wrow[2], w3 = wrow[3];
        const float wv[16] = {w0.x, w0.y, w0.z, w0.w, w1.x, w1.y, w1.z, w1.w, w2.x, w2.y, w2.z, w2.w, w3.x, w3.y, w3.z, w3.w};
#pragma unroll
        for (int t = 0; t < 2; ++t)
#pragma unroll
          for (int e = 0; e < 16; ++e) lg[t * 16 + e] += hh[t][c] * wv[e];
      }
    }
#define BFLY_STEP(OFF, N) { const bool up = (lane & (OFF)) != 0; _Pragma("unroll") for (int i = 0; i < (N); ++i) { const float a = lg[i], b = lg[i + (N)]; const float send = up ? a : b, keep = up ? b : a; lg[i] = keep + __shfl_xor(send, (OFF)); } }
    BFLY_STEP(32, 16) BFLY_STEP(16, 8) BFLY_STEP(8, 4) BFLY_STEP(4, 2) BFLY_STEP(2, 1)
#undef BFLY_STEP
    const float logit = lg[0] + __shfl_xor(lg[0], 1);
    float mx = logit;
#pragma unroll
    for (int o = 16; o >= 2; o >>= 1) mx = fmaxf(mx, __shfl_xor(mx, o));
    const float ex = expf(logit - mx);
    float den = ex;
#pragma unroll
    for (int o = 16; o >= 2; o >>= 1) den += __shfl_xor(den, o);
    if ((lane & 1) == 0) AFFT[(size_t)tok0 * 16 + (lane >> 1)] = ex / den;
  }
}

DI void topk_job(const float* __restrict__ aff, int n, int cap, int rowbase, int tokbase, int* __restrict__ SELe, int* __restrict__ ROWTOK,
                 float* __restrict__ GATEV, unsigned* sm) {
  const int tid = otid();
  unsigned* hist = sm;
  unsigned* ctl = sm + 256;
  unsigned v[32];
#pragma unroll
  for (int j = 0; j < 32; ++j) { int idx = j * 256 + tid; v[j] = idx < n ? __float_as_uint(aff[(size_t)idx * 16]) : 0u; }
  __syncthreads();
  if (tid == 0) { ctl[0] = 0u; ctl[1] = (unsigned)cap; ctl[2] = 0u; }
  __syncthreads();
  unsigned prefix = 0u, remaining = (unsigned)cap;
#pragma unroll 1
  for (int pass = 0; pass < 4; ++pass) {
    const int shift = 24 - 8 * pass;
    const unsigned hm = pass == 0 ? 0u : (0xFFFFFFFFu << (shift + 8));
    hist[tid] = 0u;
    __syncthreads();
#pragma unroll
    for (int j = 0; j < 32; ++j) {
      int idx = j * 256 + tid;
      if (idx < n && (v[j] & hm) == prefix) atomicAdd(&hist[(v[j] >> shift) & 255u], 1u);
    }
    __syncthreads();
    if (tid < 64) {
      const int L = tid;
      const unsigned h0 = hist[255 - 4 * L], h1 = hist[254 - 4 * L], h2 = hist[253 - 4 * L], h3 = hist[252 - 4 * L];
      const unsigned tot = h0 + h1 + h2 + h3;
      unsigned inc = tot;
#pragma unroll
      for (int o = 1; o < 64; o <<= 1) { const unsigned t = __shfl_up(inc, o); if (L >= o) inc += t; }
      const unsigned exc = inc - tot;
      const bool last = (L == 63);
      if ((exc < remaining && inc >= remaining) || (last && inc < remaining)) {
        unsigned c = exc;
        int bin = 255 - 4 * L;
        if (c + h0 < remaining) { c += h0; bin = 254 - 4 * L;
          if (c + h1 < remaining) { c += h1; bin = 253 - 4 * L;
            if (c + h2 < remaining) { c += h2; bin = 252 - 4 * L; } } }
        ctl[0] = prefix | ((unsigned)bin << shift);
        ctl[1] = remaining - c;
      }
    }
    __syncthreads();
    prefix = ctl[0];
    remaining = ctl[1];
    if (pass < 3) __syncthreads();
  }
  const unsigned T = prefix;
  const int lane = tid & 63, wave = tid >> 6;
  unsigned* wcG = sm + 264;
  unsigned* wcE = wcG + 128;
  unsigned* baseG = wcE + 128;
  unsigned* baseE = baseG + 128;
#pragma unroll
  for (int j = 0; j < 32; ++j) {
    const int idx = j * 256 + tid;
    const bool valid = idx < n;
    const unsigned long long bg = __ballot(valid && v[j] > T), be = __ballot(valid && v[j] == T);
    if (lane == 0) { wcG[j * 4 + wave] = (unsigned)__popcll(bg); wcE[j * 4 + wave] = (unsigned)__popcll(be); }
  }
  __syncthreads();
  {
    const unsigned* src = tid < 128 ? wcG : wcE;
    unsigned* dst = tid < 128 ? baseG : baseE;
    const int t2 = tid & 127;
    unsigned a = 0u;
    for (int i = 0; i < t2; ++i) a += src[i];
    dst[t2] = a;
  }
  __syncthreads();
  const unsigned cntGT = baseG[127] + wcG[127];
  const unsigned long long ltmask = (1ull << lane) - 1ull;
#pragma unroll
  for (int j = 0; j < 32; ++j) {
    const int idx = j * 256 + tid;
    const bool valid = idx < n;
    const bool g = valid && v[j] > T, q = valid && v[j] == T;
    const unsigned long long bg = __ballot(g), be = __ballot(q);
    int row = -1;
    if (g) row = rowbase + (int)(baseG[j * 4 + wave] + (unsigned)__popcll(bg & ltmask));
    else if (q) {
      const unsigned r = baseE[j * 4 + wave] + (unsigned)__popcll(be & ltmask);
      if (r < remaining) row = rowbase + (int)(cntGT + r);
    }
    if (valid) {
      SELe[tokbase + idx] = row;
      if (row >= 0) { ROWTOK[row] = tokbase + idx; GATEV[row] = __uint_as_float(v[j]); }
    }
  }
  __syncthreads();
}

DI void phaseH(const Params& p, int l, char* smem) {
  const float* AFFT = (const float*)(p.ws + OFF_AFFT);
  int* SEL = (int*)(p.ws + OFF_SEL);
  int* ROWTOK = (int*)(p.ws + OFF_ROWTOK);
  float* GATEV = (float*)(p.ws + OFF_GATEV);
  const int njobs = (l < 3) ? 64 : 32;
  for (int job = obid(); job < njobs; job += gridDim.x) {
    if (job < 32) {
      const int e = job >> 1, b = job & 1;
      topk_job(AFFT + (size_t)(b * 8192) * 16 + e, 8192, 1024, (e * 2 + b) * 1024, b * 8192, SEL + (size_t)e * NT, ROWTOK, GATEV, (unsigned*)smem);
    } else {
      const int j2 = job - 32;
      const int e = j2 >> 1, b = j2 & 1;
      topk_job(AFFT + (size_t)(NL + b * 256) * 16 + e, 256, 32, 32768 + (e * 2 + b) * 32, NL + b * 256, SEL + (size_t)e * NT, ROWTOK, GATEV,
               (unsigned*)smem);
    }
  }
}

DI void phaseI(const Params& p, int l, char* smem) {
  const bf16_t* HB = (const bf16_t*)(p.ws + OFF_HB);
  const bf16_t* WGU = (const bf16_t*)(p.ws + OFF_WGU) + (size_t)l * 16 * 2097152;
  const int* ROWTOK = (const int*)(p.ws + OFF_ROWTOK);
  const float* GATEV = (const float*)(p.ws + OFF_GATEV);
  bf16_t* HID = (bf16_t*)(p.ws + OFF_HID);
  const int nmt = (l < 3) ? 272 : 256;
  const int ntiles = nmt * 16;
  const int bid_ = obid();
  const bool xmap = (gridDim.x == 512);
  const int nloop = xmap ? ((l < 3 && (bid_ >> 3) < 32) ? 9 : 8) : (ntiles - bid_ + (int)gridDim.x - 1) / (int)gridDim.x;
  for (int r_ = 0; r_ < nloop; ++r_) {
    int mt, nt;
    if (xmap) {
      const int x = bid_ & 7, q = bid_ >> 3;
      if (r_ < 8) { const int e2 = x + 8 * (r_ >> 2); const int sub = (r_ & 3) * 64 + q; mt = e2 * 16 + (sub >> 4); nt = sub & 15; }
      else { mt = 256 + x + 8 * (q >> 4); nt = q & 15; }
    } else { const int id = bid_ + r_ * (int)gridDim.x; mt = id >> 4; nt = id & 15; }
    int e, row0, nvalid;
    if (mt < 256) { e = mt >> 4; row0 = mt * 128; nvalid = 128; }
    else { e = mt - 256; row0 = 32768 + e * 64; nvalid = 64; }
    gemm_tile((unsigned*)(p.ws + OFF_Y) + 8, HB, 1024, ROWTOK, row0, nvalid, WGU + (size_t)e * 2097152 + (size_t)nt * 128 * 1024, 1024, 1024, (bf16_t*)smem,
              [&](f32x4 (&acc)[4][4], int wm, int wn, int lane) {
#pragma unroll
                for (int ni = 0; ni < 2; ++ni) {
                  const int f = nt * 64 + wn * 32 + ni * 16 + (lane >> 4) * 4;
#pragma unroll
                  for (int mi = 0; mi < 4; ++mi) {
                    const int ml = wm * 64 + mi * 16 + (lane & 15);
                    if (ml < nvalid) {
                      const float gt = GATEV[row0 + ml];
                      float hv[4];
#pragma unroll
                      for (int i = 0; i < 4; ++i) hv[i] = siluf(acc[ni][mi][i]) * acc[ni + 2][mi][i] * gt;
                      uint2 o;
                      o.x = pack2(hv[0], hv[1]);
                      o.y = pack2(hv[2], hv[3]);
                      *(uint2*)(HID + (size_t)(row0 + ml) * 1024 + f) = o;
                    }
                  }
                }
              });
  }
}

DI void phaseJ(const Params& p, int l, char* smem) {
  const bf16_t* HID = (const bf16_t*)(p.ws + OFF_HID);
  const bf16_t* WD = (const bf16_t*)(p.ws + OFF_WD) + (size_t)l * 16 * 1048576;
  const float* GATEV = (const float*)(p.ws + OFF_GATEV);
  bf16_t* EOUT = (bf16_t*)(p.ws + OFF_EOUT);
  const int nmt = (l < 3) ? 272 : 256;
  const int ntiles = nmt * 8;
  const int bid_ = obid();
  const bool xmap = (gridDim.x == 512);
  const int nloop = xmap ? ((l < 3 && (bid_ >> 3) < 16) ? 5 : 4) : (ntiles - bid_ + (int)gridDim.x - 1) / (int)gridDim.x;
  for (int r_ = 0; r_ < nloop; ++r_) {
    int mt, nt;
    if (xmap) {
      const int x = bid_ & 7, q = bid_ >> 3;
      if (r_ < 4) { const int e2 = x + 8 * (r_ >> 1); const int sub = (r_ & 1) * 64 + q; mt = e2 * 16 + (sub >> 3); nt = sub & 7; }
      else { mt = 256 + x + 8 * (q >> 3); nt = q & 7; }
    } else { const int id = bid_ + r_ * (int)gridDim.x; mt = id >> 3; nt = id & 7; }
    int e, row0, nvalid;
    if (mt < 256) { e = mt >> 4; row0 = mt * 128; nvalid = 128; }
    else { e = mt - 256; row0 = 32768 + e * 64; nvalid = 64; }
    gemm_tile((unsigned*)(p.ws + OFF_Y) + 8, HID, 1024, nullptr, row0, nvalid, WD + (size_t)e * 1048576 + (size_t)nt * 128 * 1024, 1024, 1024, (bf16_t*)smem,
              [&](f32x4 (&acc)[4][4], int wm, int wn, int lane) {
#pragma unroll
                for (int mi = 0; mi < 4; ++mi) {
                  const int ml = wm * 64 + mi * 16 + (lane & 15);
                  if (ml < nvalid) {
#pragma unroll
                    for (int ni = 0; ni < 4; ++ni) {
                      const int n = nt * 128 + wn * 64 + ni * 16 + (lane >> 4) * 4;
                      uint2 o;
                      o.x = pack2(acc[ni][mi][0], acc[ni][mi][1]);
                      o.y = pack2(acc[ni][mi][2], acc[ni][mi][3]);
                      *(uint2*)(EOUT + (size_t)(row0 + ml) * 1024 + n) = o;
                    }
                  }
                }
              });
  }
}

DI void phaseK(const Params& p, int l) {
  const int ntok = (l < 3) ? NT : NL;
  const int tid_ = otid(); const int lane = tid_ & 63, wave = tid_ >> 6;
  float* XF = (float*)(p.ws + OFF_XF);
  bf16_t* HB = (bf16_t*)(p.ws + OFF_HB);
  const bf16_t* EOUT = (const bf16_t*)(p.ws + OFF_EOUT);
  const int* SEL = (const int*)(p.ws + OFF_SEL);
  const float* MODl = (const float*)(p.ws + OFF_MOD) + (size_t)l * 3 * 6144;
  const float* MODn = (const float*)(p.ws + OFF_MOD) + (size_t)(l < 3 ? l + 1 : l) * 3 * 6144;
  const float* g = p.ln2_g + l * 1024;
  const float* bb = p.ln2_b + l * 1024;
  for (int tok = obid() * 4 + wave; tok < ntok; tok += gridDim.x * 4) {
    const int set = tok_set(tok);
    const float* md = MODl + (size_t)set * 6144;
    float f[16];
#pragma unroll
    for (int q = 0; q < 16; ++q) f[q] = 0.f;
    int rowv = SEL[(size_t)(lane & 15) * NT + tok];
    {
      const int* RT = (const int*)(p.ws + OFF_ROWTOK);
      const bool okr = rowv >= 0 && rowv < NROWS_E;
      const int back = okr ? RT[rowv] : -1;
      if (back != tok) rowv = -1;
    }
#pragma unroll
    for (int e = 0; e < 16; ++e) {
      const int row = __builtin_amdgcn_readlane(rowv, e);
      if (row >= 0) {
#pragma unroll
        for (int j = 0; j < 4; ++j) {
          uint2 w = *(const uint2*)(EOUT + (size_t)row * 1024 + j * 256 + lane * 4);
          f[4 * j] += __uint_as_float(w.x << 16);
          f[4 * j + 1] += __uint_as_float(w.x & 0xffff0000u);
          f[4 * j + 2] += __uint_as_float(w.y << 16);
          f[4 * j + 3] += __uint_as_float(w.y & 0xffff0000u);
        }
      }
    }
    float v[16];
#pragma unroll
    for (int j = 0; j < 4; ++j) {
      const int col = j * 256 + lane * 4;
      float4 xv = *(const float4*)(XF + (size_t)tok * 1024 + col);
      float4 g2 = *(const float4*)(md + 5120 + col);
      v[4 * j] = ALPHA * xv.x + g2.x * f[4 * j];
      v[4 * j + 1] = ALPHA * xv.y + g2.y * f[4 * j + 1];
      v[4 * j + 2] = ALPHA * xv.z + g2.z * f[4 * j + 2];
      v[4 * j + 3] = ALPHA * xv.w + g2.w * f[4 * j + 3];
    }
    float s = 0.f;
#pragma unroll
    for (int q = 0; q < 16; ++q) s += v[q];
    const float mean = wave_sum(s) * (1.f / 1024.f);
    float qq = 0.f;
#pragma unroll
    for (int q = 0; q < 16; ++q) { float dlt = v[q] - mean; qq += dlt * dlt; }
    const float rstd = rsqrtf(wave_sum(qq) * (1.f / 1024.f) + 1e-6f);
    const float* mdn = MODn + (size_t)set * 6144;
#pragma unroll
    for (int j = 0; j < 4; ++j) {
      const int col = j * 256 + lane * 4;
      const float4 g4 = *(const float4*)(g + col), b4 = *(const float4*)(bb + col);
      float4 xn;
      xn.x = (v[4 * j] - mean) * rstd * g4.x + b4.x;
      xn.y = (v[4 * j + 1] - mean) * rstd * g4.y + b4.y;
      xn.z = (v[4 * j + 2] - mean) * rstd * g4.z + b4.z;
      xn.w = (v[4 * j + 3] - mean) * rstd * g4.w + b4.w;
      if (l < 3) {
        *(float4*)(XF + (size_t)tok * 1024 + col) = xn;
        const float4 sh = *(const float4*)(mdn + col), sc = *(const float4*)(mdn + 1024 + col);
        uint2 o;
        o.x = pack2(xn.x * (1.f + sc.x) + sh.x, xn.y * (1.f + sc.y) + sh.y);
        o.y = pack2(xn.z * (1.f + sc.z) + sh.z, xn.w * (1.f + sc.w) + sh.w);
        *(uint2*)(HB + (size_t)tok * 1024 + col) = o;
      } else {
        *(float4*)(p.out + (size_t)tok * 1024 + col) = xn;
      }
    }
  }
}


DI void probe_count(const Params& p, char* smem) {
  const int* ROWTOK = (const int*)(p.ws + OFF_ROWTOK);
  float* PV = (float*)(p.ws + OFF_Y);
  if (blockIdx.x == 0) {
    unsigned* cnt = (unsigned*)smem;
    if (threadIdx.x == 0) { cnt[0] = 0; cnt[1] = 0; }
    __syncthreads();
    for (int i = threadIdx.x; i < NROWS_E; i += 256) {
      int v = ROWTOK[i];
      if (v < 0 || v >= NT) atomicAdd(&cnt[0], 1u);
      if (i >= 32768 && (v < 0 || v >= NT)) atomicAdd(&cnt[1], 1u);
    }
    __syncthreads();
    if (threadIdx.x == 0) { PV[0] = (float)cnt[0]; PV[1] = (float)cnt[1]; }
  }
}
DI void probe_fill(const Params& p, int which) {
  const float* PV = (const float*)(p.ws + OFF_Y);
  const float v = PV[which];
  for (int i = blockIdx.x * 256 + threadIdx.x; i < NL * 1024; i += gridDim.x * 256) p.out[i] = v;
}
#define XB_TMO      128
#define XB_XCNT(j)  (256  + 64 * (j))
#define XB_XSUB(j)  (1280 + 64 * (j))
#define XB_XGEN(j)  (2304 + 64 * (j))
#define XB_TOP      3328
#define XB_TOPGEN   3392
#define XCD_BAR_WORDS 3456
#define XB_SPIN_CAP (1u << 18)
#define LAS __attribute__((address_space(3)))

__device__ __forceinline__ unsigned xb_ld(unsigned* p)              { return __hip_atomic_load(p, __ATOMIC_RELAXED, __HIP_MEMORY_SCOPE_AGENT); }
__device__ __forceinline__ unsigned xb_add(unsigned* p, unsigned v) { return __hip_atomic_fetch_add(p, v, __ATOMIC_RELAXED, __HIP_MEMORY_SCOPE_AGENT); }
__device__ __forceinline__ unsigned xb_xcc_id() { return (unsigned)__builtin_amdgcn_s_getreg((3 << 11) | 20) & 0xFu; }
#define XB_SPIN(cond, bar) do { unsigned _sp = 0; while (cond) { __builtin_amdgcn_s_sleep(1); \
    if ((++_sp & 255u) == 0u) { if (xb_ld(&(bar)[XB_TMO])) break; if (_sp > XB_SPIN_CAP) { atomicAdd(&(bar)[XB_TMO], 1u); break; } } } } while (0)

struct XcdBarrier {
    unsigned* bar; unsigned x;
    volatile LAS unsigned* st;
};

__device__ __forceinline__ XcdBarrier xcd_barrier_post(unsigned* bar, volatile LAS unsigned* st) {
    XcdBarrier b; b.bar = bar; b.x = xb_xcc_id(); b.st = st;
    if (threadIdx.x == 0) (void)xb_add(&bar[XB_XCNT(b.x)], 1u);
    return b;
}
__device__ __forceinline__ void xcd_barrier_complete(unsigned* bar, unsigned x, unsigned& nloc, unsigned& nx) {
    const unsigned G = gridDim.x * gridDim.y * gridDim.z;
    unsigned sum, cnt, mine, sp = 0u;
    for (;;) {
        sum = 0u; cnt = 0u; mine = 0u;
#pragma unroll
        for (unsigned j = 0; j < 16; ++j) { const unsigned c = xb_ld(&bar[XB_XCNT(j)]); sum += c; cnt += (c > 0u) ? 1u : 0u; mine = (j == x) ? c : mine; }
        if (sum == G) break;
        __builtin_amdgcn_s_sleep(1);
        if ((++sp & 255u) == 0u) { if (xb_ld(&bar[XB_TMO])) break; if (sp > XB_SPIN_CAP) { atomicAdd(&bar[XB_TMO], 1u); break; } }
    }
    nloc = mine > 0u ? mine : 1u; nx = cnt > 0u ? cnt : 1u;
}

__device__ __forceinline__ void xcd_barrier(const XcdBarrier& b, bool stored = true) {
    if (ALLWAVE_WB && stored) { __builtin_amdgcn_fence(__ATOMIC_RELEASE, "agent"); }
    asm volatile("s_waitcnt vmcnt(0)" ::: "memory");
    __syncthreads();
    if (threadIdx.x == 0) {
        unsigned* bar = b.bar;
        __builtin_amdgcn_s_waitcnt(0);
        unsigned nloc = b.st[0], nx = b.st[1];
        if (nloc == 0u) { xcd_barrier_complete(bar, b.x, nloc, nx); b.st[0] = nloc; b.st[1] = nx; }
        if (!ALLWAVE_WB) { __builtin_amdgcn_fence(__ATOMIC_RELEASE, "agent"); asm volatile("s_waitcnt vmcnt(0)" ::: "memory"); }
        const unsigned old = xb_add(&bar[XB_XSUB(b.x)], 1u);
        const unsigned gen = old / nloc;
        if (old + 1u == (gen + 1u) * nloc) {
            if (!ALLWAVE_WB) __builtin_amdgcn_fence(__ATOMIC_RELEASE, "agent");
            asm volatile("s_waitcnt vmcnt(0)" ::: "memory");
            const unsigned og = xb_add(&bar[XB_TOP], 1u);
            const unsigned tg = og / nx;
            if (og + 1u == (tg + 1u) * nx) xb_add(&bar[XB_TOPGEN], 1u);
            else XB_SPIN(xb_ld(&bar[XB_TOPGEN]) == tg, bar);
            __builtin_amdgcn_fence(__ATOMIC_ACQUIRE, "agent");
            xb_add(&bar[XB_XGEN(b.x)], 1u);
            asm volatile("s_waitcnt vmcnt(0)" ::: "memory");
        } else {
            XB_SPIN(xb_ld(&bar[XB_XGEN(b.x)]) == gen, bar);
            __builtin_amdgcn_fence(__ATOMIC_ACQUIRE, "agent");
            asm volatile("s_waitcnt vmcnt(0)" ::: "memory");
        }
    }
    if (BAR_DELAY && threadIdx.x == 0) { for (int q = 0; q < BAR_DELAY; ++q) __builtin_amdgcn_s_sleep(127); }
    __syncthreads();
}

#define GSYNC() xcd_barrier(xb)
#define PROBE_CHECK() { if (ph == PROBE_PH) { probe_sum(p, (const unsigned*)(p.ws + PROBE_OFF), PROBE_WORDS); GSYNC(); probe_out(p); return; } }

DI void probe_sum(const Params& p, const unsigned* buf, size_t nwords) {
  unsigned acc = 0u;
  for (size_t i = (size_t)blockIdx.x * 256 + threadIdx.x; i < nwords; i += (size_t)gridDim.x * 256) acc += buf[i] * 2654435761u + (buf[i] >> 7);
  for (int o = 32; o > 0; o >>= 1) acc += __shfl_xor(acc, o);
  if ((threadIdx.x & 63) == 0) atomicAdd((unsigned*)(p.ws + OFF_BAR) + XCD_BAR_WORDS, acc);
}
DI void probe_out(const Params& p) {
  const unsigned v = *((const unsigned*)(p.ws + OFF_BAR) + XCD_BAR_WORDS);
  const float f = (float)(v & 0xFFFFu) * (1.f / 65536.f);
  for (int i = blockIdx.x * 256 + threadIdx.x; i < NL * 1024; i += gridDim.x * 256) p.out[i] = f;
}
#if !MULTI_LAUNCH
__global__ void __launch_bounds__(256, 2) mega_kernel(Params p) {
  cg::grid_group grid = cg::this_grid();
  __shared__ __attribute__((aligned(16))) char smem[SMEM_BYTES];
  __shared__ uint4 xb_words;
  if (threadIdx.x == 0) xb_words = make_uint4(0u, 0u, 0u, 0u);
  __syncthreads();
  XcdBarrier xb = xcd_barrier_post((unsigned*)(p.ws + OFF_BAR), (volatile LAS unsigned*)&xb_words);
  grid.sync();
  int ph = 0;
#define RUNP(x) { if (ph++ >= STOP_PHASE) return; x; }
  RUNP(phase0(p, smem)); xcd_barrier(xb, (int)blockIdx.x < 385); PROBE_CHECK(); PROBE_CHECK();
  if (DBL_0) { phase0(p, smem); GSYNC(); }
  RUNP(phase0b(p)); GSYNC(); PROBE_CHECK(); PROBE_CHECK();
  for (int l = 0; l < 4; ++l) {
    RUNP(phaseA(p, l, smem)); GSYNC(); PROBE_CHECK(); PROBE_CHECK();
    if (DBL_A) { phaseA(p, l, smem); GSYNC(); }
    RUNP(phaseB(p, l, smem)); GSYNC(); PROBE_CHECK(); PROBE_CHECK();
    if (DBL_B) { phaseB(p, l, smem); GSYNC(); }
    RUNP(phaseD(p, l, smem)); xcd_barrier(xb, (int)blockIdx.x < 128); PROBE_CHECK(); PROBE_CHECK();
    if (DBL_D) { phaseD(p, l, smem); GSYNC(); }
    RUNP(phaseE(p, l, smem)); GSYNC(); PROBE_CHECK(); PROBE_CHECK();
    if (DBL_E) { phaseE(p, l, smem); GSYNC(); }
    RUNP(phaseF(p, l, smem)); GSYNC(); PROBE_CHECK(); PROBE_CHECK();
    RUNP(phaseG(p, l)); GSYNC(); PROBE_CHECK(); PROBE_CHECK();
    if (DBL_G) { phaseG(p, l); GSYNC(); }
    RUNP(phaseH(p, l, smem)); xcd_barrier(xb, (int)blockIdx.x < ((l < 3) ? 64 : 32)); PROBE_CHECK(); PROBE_CHECK();
    if (DBL_H) { phaseH(p, l, smem); GSYNC(); }

    RUNP(phaseI(p, l, smem)); GSYNC(); PROBE_CHECK(); PROBE_CHECK();
    if (DBL_I) { phaseI(p, l, smem); GSYNC(); }
    if (PROBE) { if (blockIdx.x == 0 && threadIdx.x == 0) ((float*)(p.ws + OFF_Y))[0] = (float)((unsigned*)(p.ws + OFF_Y))[8]; GSYNC(); probe_fill(p, 0); return; }
    RUNP(phaseJ(p, l, smem)); GSYNC(); PROBE_CHECK(); PROBE_CHECK();
    if (XSYNC) { for (int q = 0; q < 10; ++q) GSYNC(); }
    RUNP(phaseK(p, l));
    if (l < 3) GSYNC(); PROBE_CHECK();
  }
}
#else
template <int PH>
__global__ void __launch_bounds__(256, 2) phase_kernel(Params p, int l) {
  __shared__ __attribute__((aligned(16))) char smem[SMEM_BYTES];
  if (PH == 0) phase0(p, smem);
  if (PH == 1) phase0b(p);
  if (PH == 2) phaseA(p, l, smem);
  if (PH == 3) phaseB(p, l, smem);
  if (PH == 4) phaseD(p, l, smem);
  if (PH == 5) phaseE(p, l, smem);
  if (PH == 6) phaseF(p, l, smem);
  if (PH == 7) phaseG(p, l);
  if (PH == 8) phaseH(p, l, smem);
  if (PH == 9) phaseI(p, l, smem);
  if (PH == 10) phaseJ(p, l, smem);
  if (PH == 11) phaseK(p, l);
}
#endif

extern "C" void kernel_launch(void* const* d_in, const int* in_sizes, int n_in, void* d_out, int out_size, void* d_ws, size_t ws_size,
                              hipStream_t stream) {
  if (n_in < 27 || ws_size < WS_TOTAL) { fprintf(stderr, "kernel_launch: bad inputs (n_in %d, ws %zu need %zu)\n", n_in, ws_size, (size_t)WS_END); return; }
  Params p{};
  const float** pp = (const float**)&p;
  for (int i = 0; i < 27; ++i) pp[i] = (const float*)d_in[i];
  p.out = (float*)d_out;
  p.ws = (char*)d_ws;
#if !MULTI_LAUNCH
  static int grid_blocks = 0;
  if (!grid_blocks) {
    int dev = 0, cus = 0, per_cu = 0;
    hipGetDevice(&dev);
    hipDeviceGetAttribute(&cus, hipDeviceAttributeMultiprocessorCount, dev);
    hipOccupancyMaxActiveBlocksPerMultiprocessor(&per_cu, mega_kernel, 256, 0);
    if (per_cu < 1) per_cu = 1;
    if (per_cu > 2) per_cu = 2;
    grid_blocks = cus * per_cu;
  }
  (void)hipMemsetAsync((char*)d_ws + OFF_BAR, 0, XCD_BAR_WORDS * sizeof(unsigned) + 256, stream);
  void* args[] = {&p};
  hipError_t e = hipLaunchCooperativeKernel((void*)mega_kernel, dim3(grid_blocks), dim3(256), args, 0, stream);
  if (e != hipSuccess) fprintf(stderr, "cooperative launch failed: %s (grid %d)\n", hipGetErrorString(e), grid_blocks);
#else
  const dim3 g(512), b(256);
  phase_kernel<0><<<g, b, 0, stream>>>(p, 0);
  phase_kernel<1><<<g, b, 0, stream>>>(p, 0);
  for (int l = 0; l < 4; ++l) {
    phase_kernel<2><<<g, b, 0, stream>>>(p, l);
    phase_kernel<3><<<g, b, 0, stream>>>(p, l);
    phase_kernel<4><<<g, b, 0, stream>>>(p, l);
    phase_kernel<5><<<g, b, 0, stream>>>(p, l);
    phase_kernel<6><<<g, b, 0, stream>>>(p, l);
    phase_kernel<7><<<g, b, 0, stream>>>(p, l);
    phase_kernel<8><<<g, b, 0, stream>>>(p, l);
    phase_kernel<9><<<g, b, 0, stream>>>(p, l);
    phase_kernel<10><<<g, b, 0, stream>>>(p, l);
    phase_kernel<11><<<g, b, 0, stream>>>(p, l);
  }
#endif
}
```

```cpp
#include <hip/hip_runtime.h>
#include <hip/hip_cooperative_groups.h>
#include <cstdio>
namespace cg = cooperative_groups;

#ifndef MULTI_LAUNCH
#define MULTI_LAUNCH 0
#endif
#ifndef PROBE
#define PROBE 0
#endif
#define DBL_D 0
#define DBL_I 0
#define DBL_A 0
#define DBL_E 0
#define DBL_B 0
#define DBL_0 0
#define ALLWAVE_WB 1
#define BAR_DELAY 0
#define PROBE_PH 1000
#define PROBE_OFF OFF_EOUT
#define PROBE_WORDS ((size_t)NROWS_E * 512)
#define XSYNC 0
#define DBL_G 0
#define DBL_H 0
#ifndef STOP_PHASE
#define STOP_PHASE 100
#endif

typedef unsigned short bf16_t;
using bf16x8 = __attribute__((ext_vector_type(8))) short;
using f32x4 = __attribute__((ext_vector_type(4))) float;
using u32x4 = __attribute__((ext_vector_type(4))) unsigned;
#define DI __device__ __forceinline__
#define MFMA16(a, b, c) __builtin_amdgcn_mfma_f32_16x16x32_bf16((a), (b), (c), 0, 0, 0)

constexpr int NL = 16384;
constexpr int NC = 512;
constexpr int NT = NL + NC;
constexpr int DM = 1024;
constexpr int INW = 2112;
constexpr int LK = 8448;
constexpr int NROWS_E = 32768 + 512;
constexpr float ALPHA = 1.681792830507429f;
constexpr float LOG2E = 1.4426950408889634f;
constexpr float MLA_QS = 0.10206207261596577f * LOG2E;
constexpr float GQA_QS = 0.125f * LOG2E;
constexpr float GLA_QS = 0.17677669529663687f;
constexpr float LOG2_THETA = 13.287712379549449f;

constexpr int C_GQ = 0, C_GK = 128, C_GV = 256, C_GR = 512, C_GLRF = 768, C_MQA = 800, C_MKVA = 1184, C_MKR = 1440,
              C_AQ = 1472, C_AK = 1856, C_AV = 1984;

constexpr size_t al256(size_t x) { return (x + 255) & ~size_t(255); }
constexpr size_t OFF_MOD = 0;
constexpr size_t OFF_XF = OFF_MOD + al256((size_t)4 * 3 * 6144 * 4);
constexpr size_t OFF_HB = OFF_XF + al256((size_t)NT * DM * 4);
constexpr size_t OFF_CAT = OFF_HB + al256((size_t)NT * DM * 2);
constexpr size_t OFF_Y = OFF_CAT + al256((size_t)NT * DM * 2);
constexpr size_t OFF_PJ = OFF_Y + al256((size_t)NT * DM * 4);
constexpr size_t OFF_QM = OFF_PJ + al256((size_t)NT * INW * 2);
constexpr size_t OFF_KVM = OFF_QM + al256((size_t)NT * 576 * 2);
constexpr size_t OFF_KR = OFF_KVM + al256((size_t)NT * 768 * 2);
constexpr size_t OFF_QG = OFF_KR + al256((size_t)NT * 32 * 2);
constexpr size_t OFF_KG = OFF_QG + al256((size_t)NT * 384 * 2);
constexpr size_t OFF_VTM = OFF_KG + al256((size_t)NT * 128 * 2);
constexpr size_t OFF_VTG = OFF_VTM + al256((size_t)2 * 6 * 64 * LK * 2);
constexpr size_t OFF_U = OFF_VTG + al256((size_t)2 * 2 * 64 * LK * 2);
constexpr size_t OFF_SP = OFF_U + al256((size_t)2112 * 2048 * 4);
constexpr size_t OFF_DEC = OFF_SP + al256((size_t)2112 * 2048 * 4);
constexpr size_t OFF_HID = OFF_DEC + al256((size_t)2112 * 32 * 4);
constexpr size_t OFF_EOUT = OFF_HID + al256((size_t)NROWS_E * DM * 2);
constexpr size_t OFF_AFFT = OFF_EOUT + al256((size_t)NROWS_E * DM * 2);
constexpr size_t OFF_SEL = OFF_AFFT + al256((size_t)16 * NT * 4);
constexpr size_t OFF_ROWTOK = OFF_SEL + al256((size_t)16 * NT * 4);
constexpr size_t OFF_GATEV = OFF_ROWTOK + al256((size_t)NROWS_E * 4);
constexpr size_t OFF_WIN = OFF_GATEV + al256((size_t)NROWS_E * 4);
constexpr size_t OFF_WQB = OFF_WIN + al256((size_t)4 * 2176 * 1024 * 2);
constexpr size_t OFF_WKVB = OFF_WQB + al256((size_t)4 * 640 * 384 * 2);
constexpr size_t OFF_WOUT = OFF_WKVB + al256((size_t)4 * 768 * 256 * 2);
constexpr size_t OFF_WGU = OFF_WOUT + al256((size_t)4 * 1024 * 1024 * 2);
constexpr size_t OFF_WD = OFF_WGU + al256((size_t)64 * 2048 * 1024 * 2);
constexpr size_t WS_END = OFF_WD + al256((size_t)64 * 1024 * 1024 * 2);

constexpr size_t OFF_BAR = WS_END;
constexpr size_t OFF_TAB = WS_END + 16384;
constexpr size_t WS_TOTAL = OFF_TAB + 32768;
constexpr int SMEM_BYTES = 59392;

struct Params {
  const float *x, *c, *ctx, *c_ctx, *w_mod, *b_mod, *w_in, *w_gf, *b_gf, *w_gb, *b_gb, *g_gla, *g_qa, *w_qb, *g_kva, *w_kvb,
      *g_gq, *g_gk, *w_out, *ln1_g, *ln1_b, *w_router, *w_eg, *w_eu, *w_ed, *ln2_g, *ln2_b;
  float* out;
  char* ws;
};

DI int otid() { int t = threadIdx.x; asm volatile("" : "+v"(t)); return t; }
DI int obid() { int t = __builtin_amdgcn_workgroup_id_x(); asm volatile("" : "+s"(t)); return t; }
DI bf16_t f2bf(float f) { unsigned u = __float_as_uint(f); u += 0x7fffu + ((u >> 16) & 1u); return (bf16_t)(u >> 16); }
DI float bf2f(bf16_t b) { return __uint_as_float(((unsigned)b) << 16); }
typedef __bf16 hbf16x2 __attribute__((ext_vector_type(2)));
typedef float f32x2 __attribute__((ext_vector_type(2)));
DI unsigned pack2(float a, float b) { f32x2 v = {a, b}; return __builtin_bit_cast(unsigned, __builtin_convertvector(v, hbf16x2)); }
DI float wave_sum(float v) {
#pragma unroll
  for (int o = 32; o > 0; o >>= 1) v += __shfl_xor(v, o);
  return v;
}
DI float siluf(float x) { return x / (1.f + __expf(-x)); }
DI float logsigf(float z) { return fminf(z, 0.f) - log1pf(__expf(-fabsf(z))); }
DI int tok_set(int tok) { return tok < NL ? (tok >> 13) : 2; }
DI void tok_bp(int tok, int& b, int& pp) {
  if (tok < NL) { b = tok >> 13; pp = 256 + (tok & 8191); }
  else { int t = tok - NL; b = t >> 8; pp = t & 255; }
}

template <class Epi>
DI void gemm_tile(unsigned* g_badcnt, const bf16_t* __restrict__ A, int lda, const int* __restrict__ rowidx, int row0, int nvalid,
                  const bf16_t* __restrict__ Bt, int ldb, int K, bf16_t* smem, Epi epi) {
  const int tid = otid(), lane = tid & 63, wave = tid >> 6;
  const int wm = wave >> 1, wn = wave & 1;
  bf16_t* As = smem;
  bf16_t* Bs = smem + 128 * 72;
  const int lr = tid >> 3, lc = (tid & 7) * 8;
  const bf16_t* ap[4];
  const bf16_t* bp[4];
#pragma unroll
  for (int j = 0; j < 4; ++j) {
    int r = lr + 32 * j;
    int rr = r < nvalid ? r : 0;
    long grow = rowidx ? (long)rowidx[row0 + rr] : (long)(row0 + rr);
    if (rowidx) { if (grow < 0 || grow >= NT) grow = 0; }
    ap[j] = A + grow * lda + lc;
    bp[j] = Bt + (long)r * ldb + lc;
  }
  u32x4 raA[4], rbA[4], raB[4], rbB[4];
  const int nk = K >> 6;
#pragma unroll
  for (int j = 0; j < 4; ++j) { raA[j] = *(const u32x4*)ap[j]; rbA[j] = *(const u32x4*)bp[j]; }
  if (nk > 1) {
#pragma unroll
    for (int j = 0; j < 4; ++j) { raB[j] = *(const u32x4*)(ap[j] + 64); rbB[j] = *(const u32x4*)(bp[j] + 64); }
  }
  f32x4 acc[4][4];
#pragma unroll
  for (int a = 0; a < 4; ++a)
#pragma unroll
    for (int b = 0; b < 4; ++b) acc[a][b] = f32x4{0.f, 0.f, 0.f, 0.f};
  const int l15 = lane & 15, lg = lane >> 4;
  auto stage_and_compute = [&](u32x4 (&ra)[4], u32x4 (&rb)[4], int knext) {
    __syncthreads();
#pragma unroll
    for (int j = 0; j < 4; ++j) {
      *(u32x4*)(As + (lr + 32 * j) * 72 + lc) = ra[j];
      *(u32x4*)(Bs + (lr + 32 * j) * 72 + lc) = rb[j];
    }
    __syncthreads();
    if (knext < nk) {
#pragma unroll
      for (int j = 0; j < 4; ++j) { ra[j] = *(const u32x4*)(ap[j] + knext * 64); rb[j] = *(const u32x4*)(bp[j] + knext * 64); }
    }
    __builtin_amdgcn_sched_barrier(0);
#pragma unroll
    for (int ks = 0; ks < 2; ++ks) {
      bf16x8 af[4], wf[4];
#pragma unroll
      for (int mi = 0; mi < 4; ++mi) af[mi] = *(const bf16x8*)(As + (wm * 64 + mi * 16 + l15) * 72 + ks * 32 + lg * 8);
#pragma unroll
      for (int ni = 0; ni < 4; ++ni) wf[ni] = *(const bf16x8*)(Bs + (wn * 64 + ni * 16 + l15) * 72 + ks * 32 + lg * 8);
#pragma unroll
      for (int ni = 0; ni < 4; ++ni)
#pragma unroll
        for (int mi = 0; mi < 4; ++mi) acc[ni][mi] = MFMA16(wf[ni], af[mi], acc[ni][mi]);
    }
  };
  for (int kt = 0; kt < nk; kt += 2) {
    stage_and_compute(raA, rbA, kt + 2);
    if (kt + 1 >= nk) break;
    stage_and_compute(raB, rbB, kt + 3);
  }
  epi(acc, wm, wn, lane);
}

DI void tile_rowscale(const bf16_t* __restrict__ A, int lda, int row0, int ncols, float* rs) {
  const int tid = otid();
  const int r = tid >> 1, half = tid & 1;
  const int nh = ncols >> 1;
  const bf16_t* src = A + (long)(row0 + r) * lda + half * nh;
  float s = 0.f;
  for (int c = 0; c < nh; c += 8) {
    uint4 v = *(const uint4*)(src + c);
    unsigned w[4] = {v.x, v.y, v.z, v.w};
#pragma unroll
    for (int q = 0; q < 4; ++q) {
      float a = __uint_as_float(w[q] << 16), b = __uint_as_float(w[q] & 0xffff0000u);
      s += a * a + b * b;
    }
  }
  s += __shfl_xor(s, 1);
  if (half == 0) rs[r] = rsqrtf(s / (float)ncols + 1e-6f);
}

struct ConvDesc { const float* src; bf16_t* dst; const float* gs; int K, N, k0, n0, mode; };

DI ConvDesc conv_decode(const Params& p, int i) {
  bf16_t* WIN = (bf16_t*)(p.ws + OFF_WIN);
  bf16_t* WQB = (bf16_t*)(p.ws + OFF_WQB);
  bf16_t* WKVB = (bf16_t*)(p.ws + OFF_WKVB);
  bf16_t* WOUT = (bf16_t*)(p.ws + OFF_WOUT);
  bf16_t* WGU = (bf16_t*)(p.ws + OFF_WGU);
  bf16_t* WD = (bf16_t*)(p.ws + OFF_WD);
  ConvDesc d;
  d.gs = nullptr; d.mode = 0;
  if (i < 2176) { int l = i / 544, r = i % 544; d.src = p.w_in + (size_t)l * 1024 * INW; d.K = 1024; d.N = INW; d.k0 = (r / 34) * 64; d.n0 = (r % 34) * 64; d.dst = WIN + (size_t)l * 2176 * 1024; return d; }
  i -= 2176;
  if (i < 240) { int l = i / 60, r = i % 60; d.src = p.w_qb + (size_t)l * 384 * 576; d.K = 384; d.N = 576; d.k0 = (r / 10) * 64; d.n0 = (r % 10) * 64; d.dst = WQB + (size_t)l * 640 * 384; d.gs = p.g_qa + l * 384; return d; }
  i -= 240;
  if (i < 192) { int l = i / 48, r = i % 48; d.src = p.w_kvb + (size_t)l * 256 * 768; d.K = 256; d.N = 768; d.k0 = (r / 12) * 64; d.n0 = (r % 12) * 64; d.dst = WKVB + (size_t)l * 768 * 256; d.gs = p.g_kva + l * 256; return d; }
  i -= 192;
  if (i < 1024) { int l = i / 256, r = i % 256; d.src = p.w_out + (size_t)l * 1048576; d.K = 1024; d.N = 1024; d.k0 = (r / 16) * 64; d.n0 = (r % 16) * 64; d.dst = WOUT + (size_t)l * 1048576; return d; }
  i -= 1024;
  const int which = i / 16384, ii = i % 16384;
  const int m = ii / 256, r = ii % 256;
  d.K = 1024; d.N = 1024; d.k0 = (r / 16) * 64; d.n0 = (r % 16) * 64;
  if (which == 0) { d.src = p.w_eg + (size_t)m * 1048576; d.dst = WGU + (size_t)m * 2097152; d.mode = 1; }
  else if (which == 1) { d.src = p.w_eu + (size_t)m * 1048576; d.dst = WGU + (size_t)m * 2097152; d.mode = 2; }
  else { d.src = p.w_ed + (size_t)m * 1048576; d.dst = WD + (size_t)m * 1048576; }
  return d;
}

DI void conv_load(const ConvDesc& d, int tid, f32x4 (&v)[4], float (&sc)[4]) {
  const int c4 = (tid & 15) * 4;
#pragma unroll
  for (int j = 0; j < 4; ++j) {
    const int r = (tid >> 4) + 16 * j;
    v[j] = f32x4{0.f, 0.f, 0.f, 0.f};
    if (d.n0 + c4 < d.N) v[j] = *(const f32x4*)(d.src + (size_t)(d.k0 + r) * d.N + d.n0 + c4);
    sc[j] = d.gs ? d.gs[d.k0 + r] : 1.f;
  }
}

DI void conv_store(const ConvDesc& d, int tid, const f32x4 (&v)[4], const float (&sc)[4], float* sm) {
  __syncthreads();
  const int c4 = (tid & 15) * 4;
#pragma unroll
  for (int j = 0; j < 4; ++j) {
    const int r = (tid >> 4) + 16 * j;
    sm[r * 65 + c4 + 0] = v[j][0] * sc[j];
    sm[r * 65 + c4 + 1] = v[j][1] * sc[j];
    sm[r * 65 + c4 + 2] = v[j][2] * sc[j];
    sm[r * 65 + c4 + 3] = v[j][3] * sc[j];
  }
  __syncthreads();
  const int n = tid >> 2, ks = (tid & 3) * 16;
  unsigned w[8];
#pragma unroll
  for (int q = 0; q < 8; ++q) w[q] = pack2(sm[(ks + 2 * q) * 65 + n], sm[(ks + 2 * q + 1) * 65 + n]);
  const int gn = d.n0 + n;
  int drow = gn;
  if (d.mode != 0) drow = (gn >> 5) * 64 + (gn & 31) + (d.mode == 2 ? 32 : 0);
  uint4* dp = (uint4*)(d.dst + (size_t)drow * d.K + d.k0 + ks);
  dp[0] = make_uint4(w[0], w[1], w[2], w[3]);
  dp[1] = make_uint4(w[4], w[5], w[6], w[7]);
}

DI void phase0(const Params& p, char* smem) {
  float* sm = (float*)smem;
  float* MOD = (float*)(p.ws + OFF_MOD);
  const int NCONV = 2176 + 240 + 192 + 1024 + 3 * 16384;
  const int tid = otid();
  const int G = gridDim.x;
  {
    int it = obid();
    f32x4 v[4]; float sc[4];
    ConvDesc cur = conv_decode(p, it < NCONV ? it : 0);
    if (it < NCONV) conv_load(cur, tid, v, sc);
    while (it < NCONV) {
      const int nxt = it + G;
      f32x4 vn[4]; float scn[4];
      ConvDesc dn = conv_decode(p, nxt < NCONV ? nxt : 0);
      if (nxt < NCONV) conv_load(dn, tid, vn, scn);
      conv_store(cur, tid, v, sc, sm);
#pragma unroll
      for (int j = 0; j < 4; ++j) { v[j] = vn[j]; sc[j] = scn[j]; }
      cur = dn;
      it = nxt;
    }
  }
  for (int i = obid(); i < 385; i += G) {
    if (i >= 384) {
      float* TAB = (float*)(p.ws + OFF_TAB);
      for (int q = tid; q < 128 * 24; q += 256) {
        const int pos = q / 24, f = q % 24;
        const float invf = f < 16 ? exp2f(-(float)f * (LOG2_THETA / 16.f)) : exp2f(-(float)(f - 16) * (LOG2_THETA / 8.f));
        const float ang = (float)pos * invf;
        TAB[q * 2] = cosf(ang);
        TAB[q * 2 + 1] = sinf(ang);
      }
      continue;
    }
    {
      const int l = i / 96, n0 = (i % 96) * 64;
      const int lane = tid & 63, wave = tid >> 6;
      __syncthreads();
      for (int k = tid; k < 3072; k += 256) {
        int s = k >> 10, kk = k & 1023;
        float cv = s < 2 ? p.c[s * 1024 + kk] : p.c_ctx[kk];
        sm[k] = cv / (1.f + expf(-cv));
      }
      __syncthreads();
      float a0 = 0.f, a1 = 0.f, a2 = 0.f;
      const float* w = p.w_mod + (size_t)l * 1024 * 6144 + n0 + lane;
#pragma unroll 8
      for (int k = wave * 256; k < wave * 256 + 256; ++k) {
        float wv = w[(size_t)k * 6144];
        a0 += sm[k] * wv; a1 += sm[1024 + k] * wv; a2 += sm[2048 + k] * wv;
      }
      float* part = sm + 3072;
      part[(wave * 3 + 0) * 64 + lane] = a0;
      part[(wave * 3 + 1) * 64 + lane] = a1;
      part[(wave * 3 + 2) * 64 + lane] = a2;
      __syncthreads();
      if (tid < 192) {
        int s = tid >> 6, ln = tid & 63;
        float v2 = part[(0 * 3 + s) * 64 + ln] + part[(1 * 3 + s) * 64 + ln] + part[(2 * 3 + s) * 64 + ln] + part[(3 * 3 + s) * 64 + ln];
        MOD[(size_t)(l * 3 + s) * 6144 + n0 + ln] = v2 + p.b_mod[l * 6144 + n0 + ln];
      }
    }
  }
}

DI void phase0b(const Params& p) {
  float* XF = (float*)(p.ws + OFF_XF);
  bf16_t* HB = (bf16_t*)(p.ws + OFF_HB);
  const float* MOD = (const float*)(p.ws + OFF_MOD);
  const int total = NT * 256;
  for (int idx = obid() * 256 + otid(); idx < total; idx += gridDim.x * 256) {
    int tok = idx >> 8, c = (idx & 255) * 4;
    const float* src = tok < NL ? p.x + (size_t)tok * 1024 : p.ctx + (size_t)(tok - NL) * 1024;
    float4 v = *(const float4*)(src + c);
    *(float4*)(XF + (size_t)tok * 1024 + c) = v;
    const float* md = MOD + (size_t)tok_set(tok) * 6144;
    float4 sh = *(const float4*)(md + c), sc = *(const float4*)(md + 1024 + c);
    uint2 o;
    o.x = pack2(v.x * (1.f + sc.x) + sh.x, v.y * (1.f + sc.y) + sh.y);
    o.y = pack2(v.z * (1.f + sc.z) + sh.z, v.w * (1.f + sc.w) + sh.w);
    *(uint2*)(HB + (size_t)tok * 1024 + c) = o;
  }
}

DI void phaseA(const Params& p, int l, char* smem) {
  const bf16_t* HB = (const bf16_t*)(p.ws + OFF_HB);
  const bf16_t* WIN = (const bf16_t*)(p.ws + OFF_WIN) + (size_t)l * 2176 * 1024;
  bf16_t* PJ = (bf16_t*)(p.ws + OFF_PJ);
  const int ntiles = 132 * 17;
  const int bid_ = obid();
  const bool xmap = (gridDim.x == 512);
  const int xn = xmap ? ((132 - (bid_ & 7) + 7) >> 3) * 17 : 0;
  for (int t_ = xmap ? (bid_ >> 3) : bid_; t_ < (xmap ? xn : ntiles); t_ += (xmap ? 64 : (int)gridDim.x)) {
    const int mt = xmap ? (bid_ & 7) + 8 * (t_ / 17) : t_ / 17, nt = t_ % 17;
    gemm_tile((unsigned*)(p.ws + OFF_Y) + 8, HB, 1024, nullptr, mt * 128, 128, WIN + (size_t)nt * 128 * 1024, 1024, 1024, (bf16_t*)smem,
              [&](f32x4 (&acc)[4][4], int wm, int wn, int lane) {
#pragma unroll
                for (int ni = 0; ni < 4; ++ni) {
                  int n = nt * 128 + wn * 64 + ni * 16 + (lane >> 4) * 4;
                  if (n < INW) {
#pragma unroll
                    for (int mi = 0; mi < 4; ++mi) {
                      int m = mt * 128 + wm * 64 + mi * 16 + (lane & 15);
                      uint2 o;
                      o.x = pack2(acc[ni][mi][0], acc[ni][mi][1]);
                      o.y = pack2(acc[ni][mi][2], acc[ni][mi][3]);
                      *(uint2*)(PJ + (size_t)m * INW + n) = o;
                    }
                  }
                }
              });
  }
}

DI void gla_la8(const bf16_t* __restrict__ PJ, int tok, int dir, const float* __restrict__ W, const float* __restrict__ bias, int h, int d0,
                float* out8) {
  const bf16_t* g = PJ + (size_t)tok * INW + C_GLRF + dir * 16;
  uint4 g0 = *(const uint4*)g, g1 = *(const uint4*)(g + 8);
  unsigned gw[8] = {g0.x, g0.y, g0.z, g0.w, g1.x, g1.y, g1.z, g1.w};
  float a[8];
#pragma unroll
  for (int q = 0; q < 8; ++q) a[q] = bias[h * 32 + d0 + q];
#pragma unroll
  for (int r = 0; r < 16; ++r) {
    float gv = (r & 1) ? __uint_as_float(gw[r >> 1] & 0xffff0000u) : __uint_as_float(gw[r >> 1] << 16);
    const float* wr = W + r * 128 + h * 32 + d0;
#pragma unroll
    for (int q = 0; q < 8; ++q) a[q] += gv * wr[q];
  }
#pragma unroll
  for (int q = 0; q < 8; ++q) out8[q] = logsigf(a[q]) * (1.f / 16.f);
}

DI void gla_cumsum(const bf16_t* __restrict__ PJ, int tok0, int dir, const float* __restrict__ W, const float* __restrict__ bias, int h,
                   float* la, float* blast, float* segtot) {
  const int tid = otid();
  {
    const int t = tid >> 2, d0 = (tid & 3) * 8;
    float o8[8];
    gla_la8(PJ, tok0 + t, dir, W, bias, h, d0, o8);
#pragma unroll
    for (int q = 0; q < 8; ++q) la[t * 32 + d0 + q] = o8[q];
  }
  __syncthreads();
  const int d = tid & 31, seg = tid >> 5;
  float vals[8];
  float run = 0.f;
#pragma unroll
  for (int k = 0; k < 8; ++k) {
    const int o = seg * 8 + k;
    const int t = dir ? 63 - o : o;
    run += la[t * 32 + d];
    vals[k] = run;
  }
  segtot[seg * 32 + d] = run;
  __syncthreads();
  float off = 0.f;
#pragma unroll
  for (int sgi = 0; sgi < 7; ++sgi) off += (sgi < seg) ? segtot[sgi * 32 + d] : 0.f;
#pragma unroll
  for (int k = 0; k < 8; ++k) {
    const int o = seg * 8 + k;
    const int t = dir ? 63 - o : o;
    la[t * 32 + d] = vals[k] + off;
  }
  if (seg == 7) blast[d] = run + off;
  __syncthreads();
}

DI int chunk_tok0(int cidx) { return cidx < 256 ? cidx * 64 : NL + (cidx - 256) * 64; }

DI void gla_u_item(const Params& p, int l, int item, char* smem) {
  const bf16_t* PJ = (const bf16_t*)(p.ws + OFF_PJ);
  float* U = (float*)(p.ws + OFF_U);
  float* DEC = (float*)(p.ws + OFF_DEC);
  const int dir = item & 1, h = (item >> 1) & 3, cidx = item >> 3;
  const int tok0 = chunk_tok0(cidx);
  const float* W = (dir ? p.w_gb : p.w_gf) + l * 16 * 128;
  const float* bias = (dir ? p.b_gb : p.b_gf) + l * 128;
  float* la = (float*)smem;
  float* blast = la + 2048;
  float* segtot = blast + 32;
  bf16_t* VT = (bf16_t*)(segtot + 256);
  bf16_t* KT = VT + 64 * 72;
  const int tid = otid(), lane = tid & 63, wave = tid >> 6;
  const int l15 = lane & 15, lg = lane >> 4;
  __syncthreads();
  gla_cumsum(PJ, tok0, dir, W, bias, h, la, blast, segtot);
  {
    const int t = tid >> 2, d0 = (tid & 3) * 8;
    const bf16_t* kp = PJ + (size_t)(tok0 + t) * INW + C_GK + h * 32 + d0;
    const u32x4 kr = *(const u32x4*)kp;
#pragma unroll
    for (int q = 0; q < 8; ++q) {
      const unsigned wd = kr[q >> 1];
      const float kv = (q & 1) ? __uint_as_float(wd & 0xffff0000u) : __uint_as_float(wd << 16);
      KT[(d0 + q) * 72 + t] = f2bf(kv * __expf(blast[d0 + q] - la[t * 32 + d0 + q]));
    }
    const int e0 = (tid & 3) * 16;
    const bf16_t* vp = PJ + (size_t)(tok0 + t) * INW + C_GV + h * 64 + e0;
    const u32x4 v0 = *(const u32x4*)vp, v1 = *(const u32x4*)(vp + 8);
#pragma unroll
    for (int q = 0; q < 8; ++q) {
      const unsigned w0 = v0[q >> 1], w1 = v1[q >> 1];
      VT[(e0 + q) * 72 + t] = (bf16_t)((q & 1) ? (w0 >> 16) : (w0 & 0xffffu));
      VT[(e0 + 8 + q) * 72 + t] = (bf16_t)((q & 1) ? (w1 >> 16) : (w1 & 0xffffu));
    }
  }
  __syncthreads();
  f32x4 acc[2] = {f32x4{0.f, 0.f, 0.f, 0.f}, f32x4{0.f, 0.f, 0.f, 0.f}};
#pragma unroll
  for (int s2 = 0; s2 < 2; ++s2) {
    const bf16x8 vf = *(const bf16x8*)(VT + (wave * 16 + l15) * 72 + s2 * 32 + lg * 8);
#pragma unroll
    for (int dt = 0; dt < 2; ++dt) {
      const bf16x8 kf = *(const bf16x8*)(KT + (dt * 16 + l15) * 72 + s2 * 32 + lg * 8);
      acc[dt] = MFMA16(vf, kf, acc[dt]);
    }
  }
#pragma unroll
  for (int dt = 0; dt < 2; ++dt) {
    float* up = U + (size_t)item * 2048 + (dt * 16 + l15) * 64 + wave * 16 + lg * 4;
    *(float4*)up = make_float4(acc[dt][0], acc[dt][1], acc[dt][2], acc[dt][3]);
  }
  if (tid < 32) DEC[item * 32 + tid] = __expf(blast[tid]);
}

DI void prep_item(const Params& p, int l, int tile, char* smem) {
  const bf16_t* PJ = (const bf16_t*)(p.ws + OFF_PJ);
  bf16_t* QG = (bf16_t*)(p.ws + OFF_QG);
  bf16_t* KG = (bf16_t*)(p.ws + OFF_KG);
  bf16_t* KR = (bf16_t*)(p.ws + OFF_KR);
  bf16_t* VTG = (bf16_t*)(p.ws + OFF_VTG);
  const float* TAB = (const float*)(p.ws + OFF_TAB);
  const int tok0 = tile * 64;
  const int tid = otid(), lane = tid & 63, wave = tid >> 6;
  const bool lat = tok0 < NL;
  __syncthreads();
  for (int tt = wave; tt < 64; tt += 4) {
    const int tok = tok0 + tt;
    const bf16_t* row = PJ + (size_t)tok * INW;
    float v[8];
#pragma unroll
    for (int hh = 0; hh < 8; ++hh) v[hh] = bf2f(row[(hh < 6 ? C_AQ + hh * 64 : C_AK + (hh - 6) * 64) + lane]);
    float kr = bf2f(row[C_MKR + (lane & 31)]);
    const int t = tok & 8191;
    float csg = 1.f, sng = 0.f, csm = 1.f, snm = 0.f;
    if (lat) {
      const float2 a = *(const float2*)(TAB + ((lane < 32 ? (t >> 6) : (t & 63)) * 24 + (lane & 15)) * 2);
      csg = a.x; sng = a.y;
      const int r = lane & 31;
      const float2 m2 = *(const float2*)(TAB + (((r >> 4) ? (t & 63) : (t >> 6)) * 24 + 16 + (r & 7)) * 2);
      csm = m2.x; snm = m2.y;
    }
    const float gq = p.g_gq[l * 64 + lane], gk = p.g_gk[l * 64 + lane];
#pragma unroll
    for (int hh = 0; hh < 8; ++hh) {
      const float ss = wave_sum(v[hh] * v[hh]);
      const float rn = rsqrtf(ss * (1.f / 64.f) + 1e-6f);
      float y = v[hh] * rn * (hh < 6 ? gq : gk);
      const float partner = __shfl_xor(y, 16);
      y = ((lane >> 4) & 1) ? (partner * sng + y * csg) : (y * csg - partner * sng);
      if (hh < 6) QG[(size_t)tok * 384 + hh * 64 + lane] = f2bf(y * GQA_QS);
      else KG[(size_t)tok * 128 + (hh - 6) * 64 + lane] = f2bf(y);
    }
    {
      const float partner = __shfl_xor(kr, 8);
      const int r = lane & 31;
      kr = ((r >> 3) & 1) ? (partner * snm + kr * csm) : (kr * csm - partner * snm);
      if (lane < 32) KR[(size_t)tok * 32 + r] = f2bf(kr);
    }
  }
  bf16_t* sm = (bf16_t*)smem;
  for (int c = tid; c < 64 * 16; c += 256) {
    int t = c >> 4, cc = (c & 15) * 8;
    *(uint4*)(sm + t * 136 + cc) = *(const uint4*)(PJ + (size_t)(tok0 + t) * INW + C_AV + cc);
  }
  __syncthreads();
  {
    int b, pp;
    tok_bp(tok0, b, pp);
    const int c = tid >> 1, half = tid & 1;
    const int kvh = c >> 6, dv = c & 63;
    unsigned w[16];
#pragma unroll
    for (int q = 0; q < 16; ++q) {
      unsigned lo = sm[(half * 32 + 2 * q) * 136 + c], hi = sm[(half * 32 + 2 * q + 1) * 136 + c];
      w[q] = lo | (hi << 16);
    }
    uint4* d = (uint4*)(VTG + ((size_t)((b * 2 + kvh) * 64 + dv)) * LK + pp + half * 32);
    d[0] = make_uint4(w[0], w[1], w[2], w[3]);
    d[1] = make_uint4(w[4], w[5], w[6], w[7]);
    d[2] = make_uint4(w[8], w[9], w[10], w[11]);
    d[3] = make_uint4(w[12], w[13], w[14], w[15]);
  }
}

DI void phaseB(const Params& p, int l, char* smem) {
  const bf16_t* PJ = (const bf16_t*)(p.ws + OFF_PJ);
  const bf16_t* WQB = (const bf16_t*)(p.ws + OFF_WQB) + (size_t)l * 640 * 384;
  const bf16_t* WKVB = (const bf16_t*)(p.ws + OFF_WKVB) + (size_t)l * 768 * 256;
  bf16_t* QM = (bf16_t*)(p.ws + OFF_QM);
  bf16_t* KVM = (bf16_t*)(p.ws + OFF_KVM);
  bf16_t* VTM = (bf16_t*)(p.ws + OFF_VTM);
  float* rs = (float*)(smem + 2 * 128 * 72 * 2);
  const float* TAB = (const float*)(p.ws + OFF_TAB);
  const int N_G2 = 132 * 5, N_G3 = 132 * 6, N_PREP = 264, N_U = 2112;
  const int total = N_G2 + N_G3 + N_PREP + N_U;
  for (int it = obid(); it < total; it += gridDim.x) {
    int id = it;
    if (id < N_G2) {
      const int mt = id / 5, nt = id % 5;
      if (l == 3 && mt >= 128) continue;
      __syncthreads();
      tile_rowscale(PJ + C_MQA, INW, mt * 128, 384, rs);
      gemm_tile((unsigned*)(p.ws + OFF_Y) + 8, PJ + C_MQA, INW, nullptr, mt * 128, 128, WQB + (size_t)nt * 128 * 384, 384, 384, (bf16_t*)smem,
                [&](f32x4 (&acc)[4][4], int wm, int wn, int lane) {
#pragma unroll
                  for (int ni = 0; ni < 4; ++ni) {
                    const int n = nt * 128 + wn * 64 + ni * 16 + (lane >> 4) * 4;
                    const int d = n % 96;
#pragma unroll
                    for (int mi = 0; mi < 4; ++mi) {
                      const int ml = wm * 64 + mi * 16 + (lane & 15);
                      const int tok = mt * 128 + ml;
                      const float rsc = rs[ml];
                      float v[4], pr[4];
#pragma unroll
                      for (int i = 0; i < 4; ++i) { v[i] = acc[ni][mi][i] * rsc; pr[i] = __shfl_xor(v[i], 32); }
                      if (d >= 64 && tok < NL && n < 576) {
                        const int r = d - 64;
                        const int t = tok & 8191;
                        const int pos = (r >> 4) ? (t & 63) : (t >> 6);
                        const bool second = (r >> 3) & 1;
                        const float* tb = TAB + (pos * 24 + 16 + (r & 7)) * 2;
                        const float4 c01 = *(const float4*)tb, c23 = *(const float4*)(tb + 4);
                        const float csv[4] = {c01.x, c01.z, c23.x, c23.z}, snv[4] = {c01.y, c01.w, c23.y, c23.w};
#pragma unroll
                        for (int i = 0; i < 4; ++i) v[i] = second ? (pr[i] * snv[i] + v[i] * csv[i]) : (v[i] * csv[i] - pr[i] * snv[i]);
                      }
                      if (n < 576) {
                        uint2 o;
                        o.x = pack2(v[0] * MLA_QS, v[1] * MLA_QS);
                        o.y = pack2(v[2] * MLA_QS, v[3] * MLA_QS);
                        *(uint2*)(QM + (size_t)tok * 576 + n) = o;
                      }
                    }
                  }
                });
      continue;
    }
    id -= N_G2;
    if (id < N_G3) {
      const int mt = id / 6, nt = id % 6;
      __syncthreads();
      tile_rowscale(PJ + C_MKVA, INW, mt * 128, 256, rs);
      gemm_tile((unsigned*)(p.ws + OFF_Y) + 8, PJ + C_MKVA, INW, nullptr, mt * 128, 128, WKVB + (size_t)nt * 128 * 256, 256, 256, (bf16_t*)smem,
                [&](f32x4 (&acc)[4][4], int wm, int wn, int lane) {
#pragma unroll
                  for (int ni = 0; ni < 4; ++ni) {
                    const int cl = ni * 16 + (lane >> 4) * 4;
#pragma unroll
                    for (int mi = 0; mi < 4; ++mi) {
                      const int ml = wm * 64 + mi * 16 + (lane & 15);
                      const int tok = mt * 128 + ml;
                      const float rsc = rs[ml];
                      float v[4];
#pragma unroll
                      for (int i = 0; i < 4; ++i) v[i] = acc[ni][mi][i] * rsc;
                      if (wn == 0) {
                        uint2 o;
                        o.x = pack2(v[0], v[1]);
                        o.y = pack2(v[2], v[3]);
                        *(uint2*)(KVM + (size_t)tok * 768 + nt * 128 + cl) = o;
                      } else {
                        int b, pp;
                        tok_bp(tok, b, pp);
                        bf16_t* vt = VTM + ((size_t)((b * 6 + nt) * 64 + cl)) * LK + pp;
#pragma unroll
                        for (int i = 0; i < 4; ++i) vt[(size_t)i * LK] = f2bf(v[i]);
                      }
                    }
                  }
                });
      continue;
    }
    id -= N_G3;
    if (id < N_PREP) { prep_item(p, l, id, smem); continue; }
    id -= N_PREP;
    gla_u_item(p, l, id, smem);
  }
}

template <bool MLA>
DI void attn_item(const bf16_t* __restrict__ Qb, int ldq, const bf16_t* __restrict__ Kb, int ldk, const bf16_t* __restrict__ KRb,
                  const bf16_t* __restrict__ Vt, int b, int qtok0, int ntiles, bool ctxq, bf16_t* __restrict__ outp, bf16_t* smem) {
  constexpr int DQK = MLA ? 96 : 64;
  constexpr int KST = DQK + 8;
  constexpr int CPR = DQK / 8;
  constexpr int NKC = 64 * CPR / 256;
  constexpr int NKS = DQK / 32;
  constexpr int BUF = 64 * KST + 64 * 72;
  const int tid = otid(), lane = tid & 63, wave = tid >> 6;
  const int l15 = lane & 15, lg = lane >> 4;
  bf16x8 qf[2][NKS];
#pragma unroll
  for (int mi = 0; mi < 2; ++mi)
#pragma unroll
    for (int ks = 0; ks < NKS; ++ks)
      qf[mi][ks] = *(const bf16x8*)(Qb + (size_t)(qtok0 + wave * 32 + mi * 16 + l15) * ldq + ks * 32 + lg * 8);
  int krow[NKC], kcc[NKC];
#pragma unroll
  for (int j = 0; j < NKC; ++j) { int c = tid + 256 * j; krow[j] = c / CPR; kcc[j] = c % CPR; }
  u32x4 rk[NKC], rv[2];
  auto load_tile = [&](int kt) {
    int ktok0;
    if (ctxq || kt < 4) ktok0 = NL + b * 256 + kt * 64; else ktok0 = b * 8192 + (kt - 4) * 64;
#pragma unroll
    for (int j = 0; j < NKC; ++j) {
      const bf16_t* src;
      if (MLA && kcc[j] >= 8) src = KRb + (size_t)(ktok0 + krow[j]) * 32 + (kcc[j] - 8) * 8;
      else src = Kb + (size_t)(ktok0 + krow[j]) * ldk + kcc[j] * 8;
      rk[j] = *(const u32x4*)src;
    }
#pragma unroll
    for (int j = 0; j < 2; ++j) {
      int c = tid + 256 * j;
      rv[j] = *(const u32x4*)(Vt + (size_t)(c >> 3) * LK + kt * 64 + (c & 7) * 8);
    }
  };
  auto store_tile = [&](int buf) {
    bf16_t* Ks = smem + buf * BUF;
    bf16_t* Vs = Ks + 64 * KST;
#pragma unroll
    for (int j = 0; j < NKC; ++j) *(u32x4*)(Ks + krow[j] * KST + kcc[j] * 8) = rk[j];
#pragma unroll
    for (int j = 0; j < 2; ++j) { int c = tid + 256 * j; *(u32x4*)(Vs + (c >> 3) * 72 + (c & 7) * 8) = rv[j]; }
  };
  f32x4 o[4][2];
#pragma unroll
  for (int a = 0; a < 4; ++a)
#pragma unroll
    for (int c = 0; c < 2; ++c) o[a][c] = f32x4{0.f, 0.f, 0.f, 0.f};
  float mrun[2] = {-1e30f, -1e30f}, lrun[2] = {0.f, 0.f};
  __syncthreads();
  load_tile(0);
  store_tile(0);
  if (ntiles > 1) load_tile(1);
  __syncthreads();
  for (int kt = 0; kt < ntiles; ++kt) {
    if (kt + 1 < ntiles) {
      store_tile((kt + 1) & 1);
      if (kt + 2 < ntiles) load_tile(kt + 2);
    }
    const bf16_t* Ks = smem + (kt & 1) * BUF;
    const bf16_t* Vs = Ks + 64 * KST;
    f32x4 s[2][4];
#pragma unroll
    for (int mi = 0; mi < 2; ++mi)
#pragma unroll
      for (int ni = 0; ni < 4; ++ni) s[mi][ni] = f32x4{0.f, 0.f, 0.f, 0.f};
#pragma unroll
    for (int ks = 0; ks < NKS; ++ks) {
#pragma unroll
      for (int ni = 0; ni < 4; ++ni) {
        bf16x8 kf = *(const bf16x8*)(Ks + (ni * 16 + l15) * KST + ks * 32 + lg * 8);
#pragma unroll
        for (int mi = 0; mi < 2; ++mi) s[mi][ni] = MFMA16(kf, qf[mi][ks], s[mi][ni]);
      }
    }
    float pmx[2];
    bool need = false;
#pragma unroll
    for (int mi = 0; mi < 2; ++mi) {
      float mx = fmaxf(fmaxf(s[mi][0][0], s[mi][0][1]), fmaxf(s[mi][0][2], s[mi][0][3]));
#pragma unroll
      for (int ni = 1; ni < 4; ++ni) mx = fmaxf(mx, fmaxf(fmaxf(s[mi][ni][0], s[mi][ni][1]), fmaxf(s[mi][ni][2], s[mi][ni][3])));
      pmx[mi] = mx;
      need = need || (mx > mrun[mi] + 8.f);
    }
    if (__any(need)) {
#pragma unroll
      for (int mi = 0; mi < 2; ++mi) {
        float mx = pmx[mi];
        mx = fmaxf(mx, __shfl_xor(mx, 16));
        mx = fmaxf(mx, __shfl_xor(mx, 32));
        const float mnew = fmaxf(mrun[mi], mx);
        const float alpha = __builtin_amdgcn_exp2f(mrun[mi] - mnew);
        mrun[mi] = mnew;
        lrun[mi] *= alpha;
#pragma unroll
        for (int nd = 0; nd < 4; ++nd)
#pragma unroll
          for (int i = 0; i < 4; ++i) o[nd][mi][i] *= alpha;
      }
    }
    bf16x8 pf[2][2];
#pragma unroll
    for (int mi = 0; mi < 2; ++mi) {
      const float mref = mrun[mi];
      f32x2 rs2 = {0.f, 0.f};
#pragma unroll
      for (int ni = 0; ni < 4; ++ni) {
        f32x2 p01 = {__builtin_amdgcn_exp2f(s[mi][ni][0] - mref), __builtin_amdgcn_exp2f(s[mi][ni][1] - mref)};
        f32x2 p23 = {__builtin_amdgcn_exp2f(s[mi][ni][2] - mref), __builtin_amdgcn_exp2f(s[mi][ni][3] - mref)};
        rs2 += p01;
        rs2 += p23;
        s[mi][ni][0] = p01[0]; s[mi][ni][1] = p01[1]; s[mi][ni][2] = p23[0]; s[mi][ni][3] = p23[1];
      }
      lrun[mi] += rs2[0] + rs2[1];
#pragma unroll
      for (int s2 = 0; s2 < 2; ++s2) {
        u32x4 u = {pack2(s[mi][2 * s2][0], s[mi][2 * s2][1]), pack2(s[mi][2 * s2][2], s[mi][2 * s2][3]),
                   pack2(s[mi][2 * s2 + 1][0], s[mi][2 * s2 + 1][1]), pack2(s[mi][2 * s2 + 1][2], s[mi][2 * s2 + 1][3])};
        pf[mi][s2] = __builtin_bit_cast(bf16x8, u);
      }
    }
#pragma unroll
    for (int s2 = 0; s2 < 2; ++s2) {
#pragma unroll
      for (int nd = 0; nd < 4; ++nd) {
        const bf16_t* vb = Vs + (nd * 16 + l15) * 72 + 32 * s2 + 4 * lg;
        uint2 lo = *(const uint2*)vb, hi = *(const uint2*)(vb + 16);
        u32x4 u = {lo.x, lo.y, hi.x, hi.y};
        bf16x8 vf = __builtin_bit_cast(bf16x8, u);
#pragma unroll
        for (int mi = 0; mi < 2; ++mi) o[nd][mi] = MFMA16(vf, pf[mi][s2], o[nd][mi]);
      }
    }
    __syncthreads();
  }
#pragma unroll
  for (int mi = 0; mi < 2; ++mi) {
    float lt = lrun[mi];
    lt += __shfl_xor(lt, 16);
    lt += __shfl_xor(lt, 32);
    const float inv = 1.f / lt;
    const int q = qtok0 + wave * 32 + mi * 16 + l15;
#pragma unroll
    for (int nd = 0; nd < 4; ++nd) {
      uint2 w;
      w.x = pack2(o[nd][mi][0] * inv, o[nd][mi][1] * inv);
      w.y = pack2(o[nd][mi][2] * inv, o[nd][mi][3] * inv);
      *(uint2*)(outp + (size_t)q * 1024 + nd * 16 + lg * 4) = w;
    }
  }
}

DI void attn_dispatch(const Params& p, int combo, int qt, bool ctxq, char* smem) {
  const bf16_t* QM = (const bf16_t*)(p.ws + OFF_QM);
  const bf16_t* KVM = (const bf16_t*)(p.ws + OFF_KVM);
  const bf16_t* KR = (const bf16_t*)(p.ws + OFF_KR);
  const bf16_t* QG = (const bf16_t*)(p.ws + OFF_QG);
  const bf16_t* KG = (const bf16_t*)(p.ws + OFF_KG);
  const bf16_t* VTM = (const bf16_t*)(p.ws + OFF_VTM);
  const bf16_t* VTG = (const bf16_t*)(p.ws + OFF_VTG);
  bf16_t* CAT = (bf16_t*)(p.ws + OFF_CAT);
  const bool mla = combo < 12;
  const int c2 = mla ? combo : combo - 12;
  const int b = c2 / 6, h = c2 % 6;
  const int qtok0 = ctxq ? NL + b * 256 + qt * 128 : b * 8192 + qt * 128;
  const int ntiles = ctxq ? 4 : 132;
  if (mla)
    attn_item<true>(QM + h * 96, 576, KVM + h * 128, 768, KR, VTM + (size_t)((b * 6 + h) * 64) * LK, b, qtok0, ntiles, ctxq,
                    CAT + 256 + h * 64, (bf16_t*)smem);
  else {
    const int kvh = h / 3;
    attn_item<false>(QG + h * 64, 384, KG + kvh * 64, 128, nullptr, VTG + (size_t)((b * 2 + kvh) * 64) * LK, b, qtok0, ntiles, ctxq,
                     CAT + 640 + h * 64, (bf16_t*)smem);
  }
}

DI void scan_item(const Params& p, int item) {
  const float* __restrict__ U = (const float*)(p.ws + OFF_U);
  const float* __restrict__ DEC = (const float*)(p.ws + OFF_DEC);
  float* __restrict__ SP = (float*)(p.ws + OFF_SP);
  const int eb = item & 7, dir = (item >> 3) & 1, h = (item >> 4) & 3, b = item >> 6;
  const int idx = eb * 256 + otid();
  const int d = idx >> 6;
  float s = 0.f;
#pragma unroll 4
  for (int step = 0; step < 132; ++step) {
    int cidx;
    if (step < 4) cidx = 256 + b * 4 + (dir ? 3 - step : step);
    else { int n = step - 4; cidx = b * 128 + (dir ? 127 - n : n); }
    const int it = (cidx * 4 + h) * 2 + dir;
    const float u = U[(size_t)it * 2048 + idx];
    const float dc = DEC[it * 32 + d];
    SP[(size_t)it * 2048 + idx] = s;
    s = dc * s + u;
  }
}

DI void phaseD(const Params& p, int l, char* smem) {
  const int n_ctx = (l < 3) ? 48 : 0;
  const int bid = obid(), G = gridDim.x;
  for (int it = bid; it < 128; it += G) scan_item(p, it);
  if (G == 512) {
    for (int r = 0; r < 3; ++r) attn_dispatch(p, r * 8 + (bid & 7), bid >> 3, false, smem);
  } else {
    for (int it = bid; it < 1536; it += G) attn_dispatch(p, it >> 6, it & 63, false, smem);
  }
  for (int it = (bid + 200) % G; it < n_ctx; it += G) attn_dispatch(p, it >> 1, it & 1, true, smem);
}

DI void gla_out_item(const Params& p, int l, int item, char* smem) {
  const bf16_t* PJ = (const bf16_t*)(p.ws + OFF_PJ);
  const float* SP = (const float*)(p.ws + OFF_SP);
  bf16_t* CAT = (bf16_t*)(p.ws + OFF_CAT);
  const int h = item & 3, cidx = item >> 2;
  const int tok0 = chunk_tok0(cidx);
  float* la = (float*)smem;
  float* blast = la + 2048;
  float* segtot = blast + 32;
  bf16_t* VT = (bf16_t*)(segtot + 256);
  bf16_t* QD = VT + 64 * 72;
  bf16_t* KI = QD + 64 * 40;
  bf16_t* ST = KI + 64 * 40;
  const int tid = otid(), lane = tid & 63, wave = tid >> 6;
  const int l15 = lane & 15, lg = lane >> 4;
  const int t = tid >> 2;
  __syncthreads();
  {
    const int e0 = (tid & 3) * 16;
    const bf16_t* vp = PJ + (size_t)(tok0 + t) * INW + C_GV + h * 64 + e0;
    const u32x4 v0 = *(const u32x4*)vp, v1 = *(const u32x4*)(vp + 8);
#pragma unroll
    for (int q = 0; q < 8; ++q) {
      const unsigned w0 = v0[q >> 1], w1 = v1[q >> 1];
      VT[(e0 + q) * 72 + t] = (bf16_t)((q & 1) ? (w0 >> 16) : (w0 & 0xffffu));
      VT[(e0 + 8 + q) * 72 + t] = (bf16_t)((q & 1) ? (w1 >> 16) : (w1 & 0xffffu));
    }
  }
  f32x4 o[4];
#pragma unroll
  for (int et = 0; et < 4; ++et) o[et] = f32x4{0.f, 0.f, 0.f, 0.f};
#pragma unroll 1
  for (int dir = 0; dir < 2; ++dir) {
    const float* W = (dir ? p.w_gb : p.w_gf) + l * 16 * 128;
    const float* bias = (dir ? p.b_gb : p.b_gf) + l * 128;
    __syncthreads();
    gla_cumsum(PJ, tok0, dir, W, bias, h, la, blast, segtot);
    {
      const int d0 = (tid & 3) * 8;
      const u32x4 qr = *(const u32x4*)(PJ + (size_t)(tok0 + t) * INW + C_GQ + h * 32 + d0);
      const u32x4 kr = *(const u32x4*)(PJ + (size_t)(tok0 + t) * INW + C_GK + h * 32 + d0);
      u32x4 qo, ko;
#pragma unroll
      for (int q2 = 0; q2 < 4; ++q2) {
        const float b0 = la[t * 32 + d0 + 2 * q2], b1 = la[t * 32 + d0 + 2 * q2 + 1];
        const float q0 = __uint_as_float(qr[q2] << 16), q1 = __uint_as_float(qr[q2] & 0xffff0000u);
        const float k0 = __uint_as_float(kr[q2] << 16), k1 = __uint_as_float(kr[q2] & 0xffff0000u);
        qo[q2] = pack2(q0 * GLA_QS * __expf(b0), q1 * GLA_QS * __expf(b1));
        ko[q2] = pack2(k0 * __expf(-b0), k1 * __expf(-b1));
      }
      *(u32x4*)(QD + t * 40 + d0) = qo;
      *(u32x4*)(KI + t * 40 + d0) = ko;
      const int it = (cidx * 4 + h) * 2 + dir;
      const int sd = tid >> 3, se0 = (tid & 7) * 8;
      const float* sp = SP + (size_t)it * 2048 + sd * 64 + se0;
      const float4 s0 = *(const float4*)sp, s1 = *(const float4*)(sp + 4);
      const float sv[8] = {s0.x, s0.y, s0.z, s0.w, s1.x, s1.y, s1.z, s1.w};
#pragma unroll
      for (int q = 0; q < 8; ++q) ST[(se0 + q) * 40 + sd] = f2bf(sv[q]);
    }
    __syncthreads();
    const bf16x8 qf = *(const bf16x8*)(QD + (wave * 16 + l15) * 40 + lg * 8);
    f32x4 at[4];
#pragma unroll
    for (int jt = 0; jt < 4; ++jt) {
      const bf16x8 kf = *(const bf16x8*)(KI + (jt * 16 + l15) * 40 + lg * 8);
      at[jt] = MFMA16(kf, qf, (f32x4{0.f, 0.f, 0.f, 0.f}));
      const int i = wave * 16 + l15;
#pragma unroll
      for (int r = 0; r < 4; ++r) {
        const int j = jt * 16 + lg * 4 + r;
        const bool keep = dir ? (j >= i) : (j <= i);
        at[jt][r] = keep ? at[jt][r] : 0.f;
      }
    }
#pragma unroll
    for (int s2 = 0; s2 < 2; ++s2) {
      u32x4 u = {pack2(at[2 * s2][0], at[2 * s2][1]), pack2(at[2 * s2][2], at[2 * s2][3]),
                 pack2(at[2 * s2 + 1][0], at[2 * s2 + 1][1]), pack2(at[2 * s2 + 1][2], at[2 * s2 + 1][3])};
      const bf16x8 pf = __builtin_bit_cast(bf16x8, u);
#pragma unroll
      for (int et = 0; et < 4; ++et) {
        const bf16_t* vb = VT + (et * 16 + l15) * 72 + 32 * s2 + 4 * lg;
        const uint2 lo = *(const uint2*)vb, hi = *(const uint2*)(vb + 16);
        u32x4 vu = {lo.x, lo.y, hi.x, hi.y};
        o[et] = MFMA16(__builtin_bit_cast(bf16x8, vu), pf, o[et]);
      }
    }
#pragma unroll
    for (int et = 0; et < 4; ++et) {
      const bf16x8 sf = *(const bf16x8*)(ST + (et * 16 + l15) * 40 + lg * 8);
      o[et] = MFMA16(sf, qf, o[et]);
    }
  }
  float ss = 0.f;
#pragma unroll
  for (int et = 0; et < 4; ++et)
#pragma unroll
    for (int r = 0; r < 4; ++r) ss += o[et][r] * o[et][r];
  ss += __shfl_xor(ss, 16);
  ss += __shfl_xor(ss, 32);
  const float rn = rsqrtf(ss * (1.f / 64.f) + 1e-6f);
  const int tok = tok0 + wave * 16 + l15;
#pragma unroll
  for (int et = 0; et < 4; ++et) {
    const int e = et * 16 + lg * 4;
    const uint2 rr = *(const uint2*)(PJ + (size_t)tok * INW + C_GR + h * 64 + e);
    const float4 gg = *(const float4*)(p.g_gla + l * 64 + e);
    const float r0 = __uint_as_float(rr.x << 16), r1 = __uint_as_float(rr.x & 0xffff0000u);
    const float r2 = __uint_as_float(rr.y << 16), r3 = __uint_as_float(rr.y & 0xffff0000u);
    uint2 w;
    w.x = pack2(o[et][0] * rn * gg.x * siluf(r0), o[et][1] * rn * gg.y * siluf(r1));
    w.y = pack2(o[et][2] * rn * gg.z * siluf(r2), o[et][3] * rn * gg.w * siluf(r3));
    *(uint2*)(CAT + (size_t)tok * 1024 + h * 64 + e) = w;
  }
}

DI void phaseE(const Params& p, int l, char* smem) {
  const int n = (l < 3 ? 264 : 256) * 4;
  for (int it = obid(); it < n; it += gridDim.x) gla_out_item(p, l, it, smem);
}

DI void phaseF(const Params& p, int l, char* smem) {
  const bf16_t* CAT = (const bf16_t*)(p.ws + OFF_CAT);
  const bf16_t* WOUT = (const bf16_t*)(p.ws + OFF_WOUT) + (size_t)l * 1048576;
  const float* XF = (const float*)(p.ws + OFF_XF);
  const float* MOD = (const float*)(p.ws + OFF_MOD) + (size_t)l * 3 * 6144;
  float* Y = (float*)(p.ws + OFF_Y);
  const int nmt = (l < 3 ? 132 : 128);
  const int ntiles = nmt * 8;
  const int bid_ = obid();
  const bool xmap = (gridDim.x == 512);
  const int xn = xmap ? ((nmt - (bid_ & 7) + 7) >> 3) * 8 : 0;
  for (int t_ = xmap ? (bid_ >> 3) : bid_; t_ < (xmap ? xn : ntiles); t_ += (xmap ? 64 : (int)gridDim.x)) {
    const int mt = xmap ? (bid_ & 7) + 8 * (t_ >> 3) : (t_ >> 3), nt = t_ & 7;
    gemm_tile((unsigned*)(p.ws + OFF_Y) + 8, CAT, 1024, nullptr, mt * 128, 128, WOUT + (size_t)nt * 128 * 1024, 1024, 1024, (bf16_t*)smem,
              [&](f32x4 (&acc)[4][4], int wm, int wn, int lane) {
                const float* g1 = MOD + (size_t)tok_set(mt * 128) * 6144 + 2048;
#pragma unroll
                for (int ni = 0; ni < 4; ++ni) {
                  const int n = nt * 128 + wn * 64 + ni * 16 + (lane >> 4) * 4;
                  const float4 g = *(const float4*)(g1 + n);
#pragma unroll
                  for (int mi = 0; mi < 4; ++mi) {
                    const int m = mt * 128 + wm * 64 + mi * 16 + (lane & 15);
                    const float4 xv = *(const float4*)(XF + (size_t)m * 1024 + n);
                    float4 r;
                    r.x = ALPHA * xv.x + g.x * acc[ni][mi][0];
                    r.y = ALPHA * xv.y + g.y * acc[ni][mi][1];
                    r.z = ALPHA * xv.z + g.z * acc[ni][mi][2];
                    r.w = ALPHA * xv.w + g.w * acc[ni][mi][3];
                    *(float4*)(Y + (size_t)m * 1024 + n) = r;
                  }
                }
              });
  }
}

DI void phaseG(const Params& p, int l) {
  const int ntok = (l < 3) ? NT : NL;
  const int tid_ = otid(); const int lane = tid_ & 63, wave = tid_ >> 6;
  const float* Y = (const float*)(p.ws + OFF_Y);
  float* XF = (float*)(p.ws + OFF_XF);
  bf16_t* HB = (bf16_t*)(p.ws + OFF_HB);
  float* AFFT = (float*)(p.ws + OFF_AFFT);
  const float* MODl = (const float*)(p.ws + OFF_MOD) + (size_t)l * 3 * 6144;
  const float* g = p.ln1_g + l * 1024;
  const float* bb = p.ln1_b + l * 1024;
  const float* wr = p.w_router + (size_t)l * 1024 * 16;
  const int ngroups = ntok >> 1;
  for (int tg = obid() * 4 + wave; tg < ngroups; tg += gridDim.x * 4) {
    const int tok0 = tg * 2;
    const float* md = MODl + (size_t)tok_set(tok0) * 6144;
    float v[2][16];
#pragma unroll
    for (int t = 0; t < 2; ++t)
#pragma unroll
      for (int j = 0; j < 4; ++j) {
        float4 t4 = *(const float4*)(Y + (size_t)(tok0 + t) * 1024 + j * 256 + lane * 4);
        v[t][4 * j] = t4.x; v[t][4 * j + 1] = t4.y; v[t][4 * j + 2] = t4.z; v[t][4 * j + 3] = t4.w;
      }
    float mean[2], rstd[2];
#pragma unroll
    for (int t = 0; t < 2; ++t) {
      float s = 0.f;
#pragma unroll
      for (int q = 0; q < 16; ++q) s += v[t][q];
      mean[t] = wave_sum(s) * (1.f / 1024.f);
      float qq = 0.f;
#pragma unroll
      for (int q = 0; q < 16; ++q) { float dlt = v[t][q] - mean[t]; qq += dlt * dlt; }
      rstd[t] = rsqrtf(wave_sum(qq) * (1.f / 1024.f) + 1e-6f);
    }
    float lg[32];
#pragma unroll
    for (int q = 0; q < 32; ++q) lg[q] = 0.f;
#pragma unroll
    for (int j = 0; j < 4; ++j) {
      const int col = j * 256 + lane * 4;
      const float4 g4 = *(const float4*)(g + col), b4 = *(const float4*)(bb + col);
      const float4 sh = *(const float4*)(md + 3072 + col), sc = *(const float4*)(md + 4096 + col);
      const float gg[4] = {g4.x, g4.y, g4.z, g4.w}, bv[4] = {b4.x, b4.y, b4.z, b4.w};
      const float shv[4] = {sh.x, sh.y, sh.z, sh.w}, scv[4] = {sc.x, sc.y, sc.z, sc.w};
      float hh[2][4];
#pragma unroll
      for (int t = 0; t < 2; ++t) {
        float xn[4];
#pragma unroll
        for (int c = 0; c < 4; ++c) {
          xn[c] = (v[t][4 * j + c] - mean[t]) * rstd[t] * gg[c] + bv[c];
          hh[t][c] = xn[c] * (1.f + scv[c]) + shv[c];
        }
        *(float4*)(XF + (size_t)(tok0 + t) * 1024 + col) = make_float4(xn[0], xn[1], xn[2], xn[3]);
        uint2 o;
        o.x = pack2(hh[t][0], hh[t][1]);
        o.y = pack2(hh[t][2], hh[t][3]);
        *(uint2*)(HB + (size_t)(tok0 + t) * 1024 + col) = o;
      }
#pragma unroll
      for (int c = 0; c < 4; ++c) {
        const float4* wrow = (const float4*)(wr + (size_t)(col + c) * 16);
        const float4 w0 = wrow[0], w1 = wrow[1], w2 = wrow[2], w3 = wrow[3];
        const float wv[16] = {w0.x, w0.y, w0.z, w0.w, w1.x, w1.y, w1.z, w1.w, w2.x, w2.y, w2.z, w2.w, w3.x, w3.y, w3.z, w3.w};
#pragma unroll
        for (int t = 0; t < 2; ++t)
#pragma unroll
          for (int e = 0; e < 16; ++e) lg[t * 16 + e] += hh[t][c] * wv[e];
      }
    }
#define BFLY_STEP(OFF, N) { const bool up = (lane & (OFF)) != 0; _Pragma("unroll") for (int i = 0; i < (N); ++i) { const float a = lg[i], b = lg[i + (N)]; const float send = up ? a : b, keep = up ? b : a; lg[i] = keep + __shfl_xor(send, (OFF)); } }
    BFLY_STEP(32, 16) BFLY_STEP(16, 8) BFLY_STEP(8, 4) BFLY_STEP(4, 2) BFLY_STEP(2, 1)
#undef BFLY_STEP
    const float logit = lg[0] + __shfl_xor(lg[0], 1);
    float mx = logit;
#pragma unroll
    for (int o = 16; o >= 2; o >>= 1) mx = fmaxf(mx, __shfl_xor(mx, o));
    const float ex = expf(logit - mx);
    float den = ex;
#pragma unroll
    for (int o = 16; o >= 2; o >>= 1) den += __shfl_xor(den, o);
    if ((lane & 1) == 0) AFFT[(size_t)tok0 * 16 + (lane >> 1)] = ex / den;
  }
}

DI void topk_job(const float* __restrict__ aff, int n, int cap, int rowbase, int tokbase, int* __restrict__ SELe, int* __restrict__ ROWTOK,
                 float* __restrict__ GATEV, unsigned* sm) {
  const int tid = otid();
  unsigned* hist = sm;
  unsigned* ctl = sm + 256;
  unsigned v[32];
#pragma unroll
  for (int j = 0; j < 32; ++j) { int idx = j * 256 + tid; v[j] = idx < n ? __float_as_uint(aff[(size_t)idx * 16]) : 0u; }
  __syncthreads();
  if (tid == 0) { ctl[0] = 0u; ctl[1] = (unsigned)cap; ctl[2] = 0u; }
  __syncthreads();
  unsigned prefix = 0u, remaining = (unsigned)cap;
#pragma unroll 1
  for (int pass = 0; pass < 4; ++pass) {
    const int shift = 24 - 8 * pass;
    const unsigned hm = pass == 0 ? 0u : (0xFFFFFFFFu << (shift + 8));
    hist[tid] = 0u;
    __syncthreads();
#pragma unroll
    for (int j = 0; j < 32; ++j) {
      int idx = j * 256 + tid;
      if (idx < n && (v[j] & hm) == prefix) atomicAdd(&hist[(v[j] >> shift) & 255u], 1u);
    }
    __syncthreads();
    if (tid < 64) {
      const int L = tid;
      const unsigned h0 = hist[255 - 4 * L], h1 = hist[254 - 4 * L], h2 = hist[253 - 4 * L], h3 = hist[252 - 4 * L];
      const unsigned tot = h0 + h1 + h2 + h3;
      unsigned inc = tot;
#pragma unroll
      for (int o = 1; o < 64; o <<= 1) { const unsigned t = __shfl_up(inc, o); if (L >= o) inc += t; }
      const unsigned exc = inc - tot;
      const bool last = (L == 63);
      if ((exc < remaining && inc >= remaining) || (last && inc < remaining)) {
        unsigned c = exc;
        int bin = 255 - 4 * L;
        if (c + h0 < remaining) { c += h0; bin = 254 - 4 * L;
          if (c + h1 < remaining) { c += h1; bin = 253 - 4 * L;
            if (c + h2 < remaining) { c += h2; bin = 252 - 4 * L; } } }
        ctl[0] = prefix | ((unsigned)bin << shift);
        ctl[1] = remaining - c;
      }
    }
    __syncthreads();
    prefix = ctl[0];
    remaining = ctl[1];
    if (pass < 3) __syncthreads();
  }
  const unsigned T = prefix;
  const int lane = tid & 63, wave = tid >> 6;
  unsigned* wcG = sm + 264;
  unsigned* wcE = wcG + 128;
  unsigned* baseG = wcE + 128;
  unsigned* baseE = baseG + 128;
#pragma unroll
  for (int j = 0; j < 32; ++j) {
    const int idx = j * 256 + tid;
    const bool valid = idx < n;
    const unsigned long long bg = __ballot(valid && v[j] > T), be = __ballot(valid && v[j] == T);
    if (lane == 0) { wcG[j * 4 + wave] = (unsigned)__popcll(bg); wcE[j * 4 + wave] = (unsigned)__popcll(be); }
  }
  __syncthreads();
  {
    const unsigned* src = tid < 128 ? wcG : wcE;
    unsigned* dst = tid < 128 ? baseG : baseE;
    const int t2 = tid & 127;
    unsigned a = 0u;
    for (int i = 0; i < t2; ++i) a += src[i];
    dst[t2] = a;
  }
  __syncthreads();
  const unsigned cntGT = baseG[127] + wcG[127];
  const unsigned long long ltmask = (1ull << lane) - 1ull;
#pragma unroll
  for (int j = 0; j < 32; ++j) {
    const int idx = j * 256 + tid;
    const bool valid = idx < n;
    const bool g = valid && v[j] > T, q = valid && v[j] == T;
    const unsigned long long bg = __ballot(g), be = __ballot(q);
    int row = -1;
    if (g) row = rowbase + (int)(baseG[j * 4 + wave] + (unsigned)__popcll(bg & ltmask));
    else if (q) {
      const unsigned r = baseE[j * 4 + wave] + (unsigned)__popcll(be & ltmask);
      if (r < remaining) row = rowbase + (int)(cntGT + r);
    }
    if (valid) {
      SELe[tokbase + idx] = row;
      if (row >= 0) { ROWTOK[row] = tokbase + idx; GATEV[row] = __uint_as_float(v[j]); }
    }
  }
  __syncthreads();
}

DI void phaseH(const Params& p, int l, char* smem) {
  const float* AFFT = (const float*)(p.ws + OFF_AFFT);
  int* SEL = (int*)(p.ws + OFF_SEL);
  int* ROWTOK = (int*)(p.ws + OFF_ROWTOK);
  float* GATEV = (float*)(p.ws + OFF_GATEV);
  const int njobs = (l < 3) ? 64 : 32;
  for (int job = obid(); job < njobs; job += gridDim.x) {
    if (job < 32) {
      const int e = job >> 1, b = job & 1;
      topk_job(AFFT + (size_t)(b * 8192) * 16 + e, 8192, 1024, (e * 2 + b) * 1024, b * 8192, SEL + (size_t)e * NT, ROWTOK, GATEV, (unsigned*)smem);
    } else {
      const int j2 = job - 32;
      const int e = j2 >> 1, b = j2 & 1;
      topk_job(AFFT + (size_t)(NL + b * 256) * 16 + e, 256, 32, 32768 + (e * 2 + b) * 32, NL + b * 256, SEL + (size_t)e * NT, ROWTOK, GATEV,
               (unsigned*)smem);
    }
  }
}

DI void phaseI(const Params& p, int l, char* smem) {
  const bf16_t* HB = (const bf16_t*)(p.ws + OFF_HB);
  const bf16_t* WGU = (const bf16_t*)(p.ws + OFF_WGU) + (size_t)l * 16 * 2097152;
  const int* ROWTOK = (const int*)(p.ws + OFF_ROWTOK);
  const float* GATEV = (const float*)(p.ws + OFF_GATEV);
  bf16_t* HID = (bf16_t*)(p.ws + OFF_HID);
  const int nmt = (l < 3) ? 272 : 256;
  const int ntiles = nmt * 16;
  const int bid_ = obid();
  const bool xmap = (gridDim.x == 512);
  const int nloop = xmap ? ((l < 3 && (bid_ >> 3) < 32) ? 9 : 8) : (ntiles - bid_ + (int)gridDim.x - 1) / (int)gridDim.x;
  for (int r_ = 0; r_ < nloop; ++r_) {
    int mt, nt;
    if (xmap) {
      const int x = bid_ & 7, q = bid_ >> 3;
      if (r_ < 8) { const int e2 = x + 8 * (r_ >> 2); const int sub = (r_ & 3) * 64 + q; mt = e2 * 16 + (sub >> 4); nt = sub & 15; }
      else { mt = 256 + x + 8 * (q >> 4); nt = q & 15; }
    } else { const int id = bid_ + r_ * (int)gridDim.x; mt = id >> 4; nt = id & 15; }
    int e, row0, nvalid;
    if (mt < 256) { e = mt >> 4; row0 = mt * 128; nvalid = 128; }
    else { e = mt - 256; row0 = 32768 + e * 64; nvalid = 64; }
    gemm_tile((unsigned*)(p.ws + OFF_Y) + 8, HB, 1024, ROWTOK, row0, nvalid, WGU + (size_t)e * 2097152 + (size_t)nt * 128 * 1024, 1024, 1024, (bf16_t*)smem,
              [&](f32x4 (&acc)[4][4], int wm, int wn, int lane) {
#pragma unroll
                for (int ni = 0; ni < 2; ++ni) {
                  const int f = nt * 64 + wn * 32 + ni * 16 + (lane >> 4) * 4;
#pragma unroll
                  for (int mi = 0; mi < 4; ++mi) {
                    const int ml = wm * 64 + mi * 16 + (lane & 15);
                    if (ml < nvalid) {
                      const float gt = GATEV[row0 + ml];
                      float hv[4];
#pragma unroll
                      for (int i = 0; i < 4; ++i) hv[i] = siluf(acc[ni][mi][i]) * acc[ni + 2][mi][i] * gt;
                      uint2 o;
                      o.x = pack2(hv[0], hv[1]);
                      o.y = pack2(hv[2], hv[3]);
                      *(uint2*)(HID + (size_t)(row0 + ml) * 1024 + f) = o;
                    }
                  }
                }
              });
  }
}

DI void phaseJ(const Params& p, int l, char* smem) {
  const bf16_t* HID = (const bf16_t*)(p.ws + OFF_HID);
  const bf16_t* WD = (const bf16_t*)(p.ws + OFF_WD) + (size_t)l * 16 * 1048576;
  const float* GATEV = (const float*)(p.ws + OFF_GATEV);
  bf16_t* EOUT = (bf16_t*)(p.ws + OFF_EOUT);
  const int nmt = (l < 3) ? 272 : 256;
  const int ntiles = nmt * 8;
  const int bid_ = obid();
  const bool xmap = (gridDim.x == 512);
  const int nloop = xmap ? ((l < 3 && (bid_ >> 3) < 16) ? 5 : 4) : (ntiles - bid_ + (int)gridDim.x - 1) / (int)gridDim.x;
  for (int r_ = 0; r_ < nloop; ++r_) {
    int mt, nt;
    if (xmap) {
      const int x = bid_ & 7, q = bid_ >> 3;
      if (r_ < 4) { const int e2 = x + 8 * (r_ >> 1); const int sub = (r_ & 1) * 64 + q; mt = e2 * 16 + (sub >> 3); nt = sub & 7; }
      else { mt = 256 + x + 8 * (q >> 3); nt = q & 7; }
    } else { const int id = bid_ + r_ * (int)gridDim.x; mt = id >> 3; nt = id & 7; }
    int e, row0, nvalid;
    if (mt < 256) { e = mt >> 4; row0 = mt * 128; nvalid = 128; }
    else { e = mt - 256; row0 = 32768 + e * 64; nvalid = 64; }
    gemm_tile((unsigned*)(p.ws + OFF_Y) + 8, HID, 1024, nullptr, row0, nvalid, WD + (size_t)e * 1048576 + (size_t)nt * 128 * 1024, 1024, 1024, (bf16_t*)smem,
              [&](f32x4 (&acc)[4][4], int wm, int wn, int lane) {
#pragma unroll
                for (int mi = 0; mi < 4; ++mi) {
                  const int ml = wm * 64 + mi * 16 + (lane & 15);
                  if (ml < nvalid) {
#pragma unroll
                    for (int ni = 0; ni < 4; ++ni) {
                      const int n = nt * 128 + wn * 64 + ni * 16 + (lane >> 4) * 4;
                      uint2 o;
                      o.x = pack2(acc[ni][mi][0], acc[ni][mi][1]);
                      o.y = pack2(acc[ni][mi][2], acc[ni][mi][3]);
                      *(uint2*)(EOUT + (size_t)(row0 + ml) * 1024 + n) = o;
                    }
                  }
                }
              });
  }
}

DI void phaseK(const Params& p, int l) {
  const int ntok = (l < 3) ? NT : NL;
  const int tid_ = otid(); const int lane = tid_ & 63, wave = tid_ >> 6;
  float* XF = (float*)(p.ws + OFF_XF);
  bf16_t* HB = (bf16_t*)(p.ws + OFF_HB);
  const bf16_t* EOUT = (const bf16_t*)(p.ws + OFF_EOUT);
  const int* SEL = (const int*)(p.ws + OFF_SEL);
  const float* MODl = (const float*)(p.ws + OFF_MOD) + (size_t)l * 3 * 6144;
  const float* MODn = (const float*)(p.ws + OFF_MOD) + (size_t)(l < 3 ? l + 1 : l) * 3 * 6144;
  const float* g = p.ln2_g + l * 1024;
  const float* bb = p.ln2_b + l * 1024;
  for (int tok = obid() * 4 + wave; tok < ntok; tok += gridDim.x * 4) {
    const int set = tok_set(tok);
    const float* md = MODl + (size_t)set * 6144;
    float f[16];
#pragma unroll
    for (int q = 0; q < 16; ++q) f[q] = 0.f;
    int rowv = SEL[(size_t)(lane & 15) * NT + tok];
    {
      const int* RT = (const int*)(p.ws + OFF_ROWTOK);
      const bool okr = rowv >= 0 && rowv < NROWS_E;
      const int back = okr ? RT[rowv] : -1;
      if (back != tok) rowv = -1;
    }
#pragma unroll
    for (int e = 0; e < 16; ++e) {
      const int row = __builtin_amdgcn_readlane(rowv, e);
      if (row >= 0) {
#pragma unroll
        for (int j = 0; j < 4; ++j) {
          uint2 w = *(const uint2*)(EOUT + (size_t)row * 1024 + j * 256 + lane * 4);
          f[4 * j] += __uint_as_float(w.x << 16);
          f[4 * j + 1] += __uint_as_float(w.x & 0xffff0000u);
          f[4 * j + 2] += __uint_as_float(w.y << 16);
          f[4 * j + 3] += __uint_as_float(w.y & 0xffff0000u);
        }
      }
    }
    float v[16];
#pragma unroll
    for (int j = 0; j < 4; ++j) {
      const int col = j * 256 + lane * 4;
      float4 xv = *(const float4*)(XF + (size_t)tok * 1024 + col);
      float4 g2 = *(const float4*)(md + 5120 + col);
      v[4 * j] = ALPHA * xv.x + g2.x * f[4 * j];
      v[4 * j + 1] = ALPHA * xv.y + g2.y * f[4 * j + 1];
      v[4 * j + 2] = ALPHA * xv.z + g2.z * f[4 * j + 2];
      v[4 * j + 3] = ALPHA * xv.w + g2.w * f[4 * j + 3];
    }
    float s = 0.f;
#pragma unroll
    for (int q = 0; q < 16; ++q) s += v[q];
    const float mean = wave_sum(s) * (1.f / 1024.f);
    float qq = 0.f;
#pragma unroll
    for (int q = 0; q < 16; ++q) { float dlt = v[q] - mean; qq += dlt * dlt; }
    const float rstd = rsqrtf(wave_sum(qq) * (1.f / 1024.f) + 1e-6f);
    const float* mdn = MODn + (size_t)set * 6144;
#pragma unroll
    for (int j = 0; j < 4; ++j) {
      const int col = j * 256 + lane * 4;
      const float4 g4 = *(const float4*)(g + col), b4 = *(const float4*)(bb + col);
      float4 xn;
      xn.x = (v[4 * j] - mean) * rstd * g4.x + b4.x;
      xn.y = (v[4 * j + 1] - mean) * rstd * g4.y + b4.y;
      xn.z = (v[4 * j + 2] - mean) * rstd * g4.z + b4.z;
      xn.w = (v[4 * j + 3] - mean) * rstd * g4.w + b4.w;
      if (l < 3) {
        *(float4*)(XF + (size_t)tok * 1024 + col) = xn;
        const float4 sh = *(const float4*)(mdn + col), sc = *(const float4*)(mdn + 1024 + col);
        uint2 o;
        o.x = pack2(xn.x * (1.f + sc.x) + sh.x, xn.y * (1.f + sc.y) + sh.y);
        o.y = pack2(xn.z * (1.f + sc.z) + sh.z, xn.w * (1.f + sc.w) + sh.w);
        *(uint2*)(HB + (size_t)tok * 1024 + col) = o;
      } else {
        *(float4*)(p.out + (size_t)tok * 1024 + col) = xn;
      }
    }
  }
}


DI void probe_count(const Params& p, char* smem) {
  const int* ROWTOK = (const int*)(p.ws + OFF_ROWTOK);
  float* PV = (float*)(p.ws + OFF_Y);
  if (blockIdx.x == 0) {
    unsigned* cnt = (unsigned*)smem;
    if (threadIdx.x == 0) { cnt[0] = 0; cnt[1] = 0; }
    __syncthreads();
    for (int i = threadIdx.x; i < NROWS_E; i += 256) {
      int v = ROWTOK[i];
      if (v < 0 || v >= NT) atomicAdd(&cnt[0], 1u);
      if (i >= 32768 && (v < 0 || v >= NT)) atomicAdd(&cnt[1], 1u);
    }
    __syncthreads();
    if (threadIdx.x == 0) { PV[0] = (float)cnt[0]; PV[1] = (float)cnt[1]; }
  }
}
DI void probe_fill(const Params& p, int which) {
  const float* PV = (const float*)(p.ws + OFF_Y);
  const float v = PV[which];
  for (int i = blockIdx.x * 256 + threadIdx.x; i < NL * 1024; i += gridDim.x * 256) p.out[i] = v;
}
#define XB_TMO      128
#define XB_XCNT(j)  (256  + 64 * (j))
#define XB_XSUB(j)  (1280 + 64 * (j))
#define XB_XGEN(j)  (2304 + 64 * (j))
#define XB_TOP      3328
#define XB_TOPGEN   3392
#define XCD_BAR_WORDS 3456
#define XB_SPIN_CAP (1u << 18)
#define LAS __attribute__((address_space(3)))

__device__ __forceinline__ unsigned xb_ld(unsigned* p)              { return __hip_atomic_load(p, __ATOMIC_RELAXED, __HIP_MEMORY_SCOPE_AGENT); }
__device__ __forceinline__ unsigned xb_add(unsigned* p, unsigned v) { return __hip_atomic_fetch_add(p, v, __ATOMIC_RELAXED, __HIP_MEMORY_SCOPE_AGENT); }
__device__ __forceinline__ unsigned xb_xcc_id() { return (unsigned)__builtin_amdgcn_s_getreg((3 << 11) | 20) & 0xFu; }
#define XB_SPIN(cond, bar) do { unsigned _sp = 0; while (cond) { __builtin_amdgcn_s_sleep(1); \
    if ((++_sp & 255u) == 0u) { if (xb_ld(&(bar)[XB_TMO])) break; if (_sp > XB_SPIN_CAP) { atomicAdd(&(bar)[XB_TMO], 1u); break; } } } } while (0)

struct XcdBarrier {
    unsigned* bar; unsigned x;
    volatile LAS unsigned* st;
};

__device__ __forceinline__ XcdBarrier xcd_barrier_post(unsigned* bar, volatile LAS unsigned* st) {
    XcdBarrier b; b.bar = bar; b.x = xb_xcc_id(); b.st = st;
    if (threadIdx.x == 0) (void)xb_add(&bar[XB_XCNT(b.x)], 1u);
    return b;
}
__device__ __forceinline__ void xcd_barrier_complete(unsigned* bar, unsigned x, unsigned& nloc, unsigned& nx) {
    const unsigned G = gridDim.x * gridDim.y * gridDim.z;
    unsigned sum, cnt, mine, sp = 0u;
    for (;;) {
        sum = 0u; cnt = 0u; mine = 0u;
#pragma unroll
        for (unsigned j = 0; j < 16; ++j) { const unsigned c = xb_ld(&bar[XB_XCNT(j)]); sum += c; cnt += (c > 0u) ? 1u : 0u; mine = (j == x) ? c : mine; }
        if (sum == G) break;
        __builtin_amdgcn_s_sleep(1);
        if ((++sp & 255u) == 0u) { if (xb_ld(&bar[XB_TMO])) break; if (sp > XB_SPIN_CAP) { atomicAdd(&bar[XB_TMO], 1u); break; } }
    }
    nloc = mine > 0u ? mine : 1u; nx = cnt > 0u ? cnt : 1u;
}

__device__ __forceinline__ void xcd_barrier(const XcdBarrier& b, bool stored = true) {
    if (ALLWAVE_WB && stored) { __builtin_amdgcn_fence(__ATOMIC_RELEASE, "agent"); }
    asm volatile("s_waitcnt vmcnt(0)" ::: "memory");
    __syncthreads();
    if (threadIdx.x == 0) {
        unsigned* bar = b.bar;
        __builtin_amdgcn_s_waitcnt(0);
        unsigned nloc = b.st[0], nx = b.st[1];
        if (nloc == 0u) { xcd_barrier_complete(bar, b.x, nloc, nx); b.st[0] = nloc; b.st[1] = nx; }
        if (!ALLWAVE_WB) { __builtin_amdgcn_fence(__ATOMIC_RELEASE, "agent"); asm volatile("s_waitcnt vmcnt(0)" ::: "memory"); }
        const unsigned old = xb_add(&bar[XB_XSUB(b.x)], 1u);
        const unsigned gen = old / nloc;
        if (old + 1u == (gen + 1u) * nloc) {
            if (!ALLWAVE_WB) __builtin_amdgcn_fence(__ATOMIC_RELEASE, "agent");
            asm volatile("s_waitcnt vmcnt(0)" ::: "memory");
            const unsigned og = xb_add(&bar[XB_TOP], 1u);
            const unsigned tg = og / nx;
            if (og + 1u == (tg + 1u) * nx) xb_add(&bar[XB_TOPGEN], 1u);
            else XB_SPIN(xb_ld(&bar[XB_TOPGEN]) == tg, bar);
            __builtin_amdgcn_fence(__ATOMIC_ACQUIRE, "agent");
            xb_add(&bar[XB_XGEN(b.x)], 1u);
            asm volatile("s_waitcnt vmcnt(0)" ::: "memory");
        } else {
            XB_SPIN(xb_ld(&bar[XB_XGEN(b.x)]) == gen, bar);
            __builtin_amdgcn_fence(__ATOMIC_ACQUIRE, "agent");
            asm volatile("s_waitcnt vmcnt(0)" ::: "memory");
        }
    }
    if (BAR_DELAY && threadIdx.x == 0) { for (int q = 0; q < BAR_DELAY; ++q) __builtin_amdgcn_s_sleep(127); }
    __syncthreads();
}

#define GSYNC() xcd_barrier(xb)
#define PROBE_CHECK() { if (ph == PROBE_PH) { probe_sum(p, (const unsigned*)(p.ws + PROBE_OFF), PROBE_WORDS); GSYNC(); probe_out(p); return; } }

DI void probe_sum(const Params& p, const unsigned* buf, size_t nwords) {
  unsigned acc = 0u;
  for (size_t i = (size_t)blockIdx.x * 256 + threadIdx.x; i < nwords; i += (size_t)gridDim.x * 256) acc += buf[i] * 2654435761u + (buf[i] >> 7);
  for (int o = 32; o > 0; o >>= 1) acc += __shfl_xor(acc, o);
  if ((threadIdx.x & 63) == 0) atomicAdd((unsigned*)(p.ws + OFF_BAR) + XCD_BAR_WORDS, acc);
}
DI void probe_out(const Params& p) {
  const unsigned v = *((const unsigned*)(p.ws + OFF_BAR) + XCD_BAR_WORDS);
  const float f = (float)(v & 0xFFFFu) * (1.f / 65536.f);
  for (int i = blockIdx.x * 256 + threadIdx.x; i < NL * 1024; i += gridDim.x * 256) p.out[i] = f;
}
#if !MULTI_LAUNCH
__global__ void __launch_bounds__(256, 2) mega_kernel(Params p) {
  cg::grid_group grid = cg::this_grid();
  __shared__ __attribute__((aligned(16))) char smem[SMEM_BYTES];
  __shared__ uint4 xb_words;
  if (threadIdx.x == 0) xb_words = make_uint4(0u, 0u, 0u, 0u);
  __syncthreads();
  XcdBarrier xb = xcd_barrier_post((unsigned*)(p.ws + OFF_BAR), (volatile LAS unsigned*)&xb_words);
  grid.sync();
  int ph = 0;
#define RUNP(x) { if (ph++ >= STOP_PHASE) return; x; }
  RUNP(phase0(p, smem)); xcd_barrier(xb, (int)blockIdx.x < 385); PROBE_CHECK(); PROBE_CHECK();
  if (DBL_0) { phase0(p, smem); GSYNC(); }
  RUNP(phase0b(p)); GSYNC(); PROBE_CHECK(); PROBE_CHECK();
  for (int l = 0; l < 4; ++l) {
    RUNP(phaseA(p, l, smem)); GSYNC(); PROBE_CHECK(); PROBE_CHECK();
    if (DBL_A) { phaseA(p, l, smem); GSYNC(); }
    RUNP(phaseB(p, l, smem)); GSYNC(); PROBE_CHECK(); PROBE_CHECK();
    if (DBL_B) { phaseB(p, l, smem); GSYNC(); }
    RUNP(phaseD(p, l, smem)); xcd_barrier(xb, (int)blockIdx.x < 128); PROBE_CHECK(); PROBE_CHECK();
    if (DBL_D) { phaseD(p, l, smem); GSYNC(); }
    RUNP(phaseE(p, l, smem)); GSYNC(); PROBE_CHECK(); PROBE_CHECK();
    if (DBL_E) { phaseE(p, l, smem); GSYNC(); }
    RUNP(phaseF(p, l, smem)); GSYNC(); PROBE_CHECK(); PROBE_CHECK();
    RUNP(phaseG(p, l)); GSYNC(); PROBE_CHECK(); PROBE_CHECK();
    if (DBL_G) { phaseG(p, l); GSYNC(); }
    RUNP(phaseH(p, l, smem)); xcd_barrier(xb, (int)blockIdx.x < ((l < 3) ? 64 : 32)); PROBE_CHECK(); PROBE_CHECK();
    if (DBL_H) { phaseH(p, l, smem); GSYNC(); }

    RUNP(phaseI(p, l, smem)); GSYNC(); PROBE_CHECK(); PROBE_CHECK();
    if (DBL_I) { phaseI(p, l, smem); GSYNC(); }
    if (PROBE) { if (blockIdx.x == 0 && threadIdx.x == 0) ((float*)(p.ws + OFF_Y))[0] = (float)((unsigned*)(p.ws + OFF_Y))[8]; GSYNC(); probe_fill(p, 0); return; }
    RUNP(phaseJ(p, l, smem)); GSYNC(); PROBE_CHECK(); PROBE_CHECK();
    if (XSYNC) { for (int q = 0; q < 10; ++q) GSYNC(); }
    RUNP(phaseK(p, l));
    if (l < 3) GSYNC(); PROBE_CHECK();
  }
}
#else
template <int PH>
__global__ void __launch_bounds__(256, 2) phase_kernel(Params p, int l) {
  __shared__ __attribute__((aligned(16))) char smem[SMEM_BYTES];
  if (PH == 0) phase0(p, smem);
  if (PH == 1) phase0b(p);
  if (PH == 2) phaseA(p, l, smem);
  if (PH == 3) phaseB(p, l, smem);
  if (PH == 4) phaseD(p, l, smem);
  if (PH == 5) phaseE(p, l, smem);
  if (PH == 6) phaseF(p, l, smem);
  if (PH == 7) phaseG(p, l);
  if (PH == 8) phaseH(p, l, smem);
  if (PH == 9) phaseI(p, l, smem);
  if (PH == 10) phaseJ(p, l, smem);
  if (PH == 11) phaseK(p, l);
}
#endif

extern "C" void kernel_launch(void* const* d_in, const int* in_sizes, int n_in, void* d_out, int out_size, void* d_ws, size_t ws_size,
                              hipStream_t stream) {
  if (n_in < 27 || ws_size < WS_TOTAL) { fprintf(stderr, "kernel_launch: bad inputs (n_in %d, ws %zu need %zu)\n", n_in, ws_size, (size_t)WS_END); return; }
  Params p{};
  const float** pp = (const float**)&p;
  for (int i = 0; i < 27; ++i) pp[i] = (const float*)d_in[i];
  p.out = (float*)d_out;
  p.ws = (char*)d_ws;
#if !MULTI_LAUNCH
  static int grid_blocks = 0;
  if (!grid_blocks) {
    int dev = 0, cus = 0, per_cu = 0;
    hipGetDevice(&dev);
    hipDeviceGetAttribute(&cus, hipDeviceAttributeMultiprocessorCount, dev);
    hipOccupancyMaxActiveBlocksPerMultiprocessor(&per_cu, mega_kernel, 256, 0);
    if (per_cu < 1) per_cu = 1;
    if (per_cu > 2) per_cu = 2;
    grid_blocks = cus * per_cu;
  }
  (void)hipMemsetAsync((char*)d_ws + OFF_BAR, 0, XCD_BAR_WORDS * sizeof(unsigned) + 256, stream);
  void* args[] = {&p};
  hipError_t e = hipLaunchCooperativeKernel((void*)mega_kernel, dim3(grid_blocks), dim3(256), args, 0, stream);
  if (e != hipSuccess) fprintf(stderr, "cooperative launch failed: %s (grid %d)\n", hipGetErrorString(e), grid_blocks);
#else
  const dim3 g(512), b(256);
  phase_kernel<0><<<g, b, 0, stream>>>(p, 0);
  phase_kernel<1><<<g, b, 0, stream>>>(p, 0);
  for (int l = 0; l < 4; ++l) {
    phase_kernel<2><<<g, b, 0, stream>>>(p, l);
    phase_kernel<3><<<g, b, 0, stream>>>(p, l);
    phase_kernel<4><<<g, b, 0, stream>>>(p, l);
    phase_kernel<5><<<g, b, 0, stream>>>(p, l);
    phase_kernel<6><<<g, b, 0, stream>>>(p, l);
    phase_kernel<7><<<g, b, 0, stream>>>(p, l);
    phase_kernel<8><<<g, b, 0, stream>>>(p, l);
    phase_kernel<9><<<g, b, 0, stream>>>(p, l);
    phase_kernel<10><<<g, b, 0, stream>>>(p, l);
    phase_kernel<11><<<g, b, 0, stream>>>(p, l);
  }
#endif
}
```
